# Optimizing an MI355X kernel written in HIP

```python
import jax, jax.numpy as jnp
from jax import lax
import numpy as np

D_MODEL = 1024
BATCH = 8
SEQ = 4096
DEPTH = 2

HEAD_DIM = 64
N_HEADS_FOX = 4
N_HEADS_NSA = 4
N_HEADS_SWA = 4
N_KV_SWA = 2
N_HEADS_DIL = 4
N_HEADS_MIX = N_HEADS_FOX + N_HEADS_NSA + N_HEADS_SWA + N_HEADS_DIL
D_MIX = N_HEADS_MIX * HEAD_DIM
D_FF = 2816
BLOCK = 128
NSA_CMP_LEN = 32
NSA_CMP_STRIDE = 16
NSA_CMP_HIDDEN = 128
NSA_SEL_LEN = 64
NSA_TOPN = 16
NSA_WINDOW = 512
SWA_WINDOW = 128
DIL_PAIRS = ((128, 1), (512, 4), (2048, 16))
RMS_EPS = 1e-6

IN_SPLITS = (
    ('fox_q', N_HEADS_FOX * HEAD_DIM), ('fox_k', N_HEADS_FOX * HEAD_DIM),
    ('fox_v', N_HEADS_FOX * HEAD_DIM), ('fox_f', N_HEADS_FOX),
    ('nsa_q', N_HEADS_NSA * HEAD_DIM),
    ('nsa_k_cmp', HEAD_DIM), ('nsa_v_cmp', HEAD_DIM),
    ('nsa_k_slc', HEAD_DIM), ('nsa_v_slc', HEAD_DIM),
    ('nsa_k_win', HEAD_DIM), ('nsa_v_win', HEAD_DIM),
    ('nsa_gate', 3 * N_HEADS_NSA),
    ('swa_q', N_HEADS_SWA * HEAD_DIM), ('swa_k', N_KV_SWA * HEAD_DIM), ('swa_v', N_KV_SWA * HEAD_DIM),
    ('dil_q', N_HEADS_DIL * HEAD_DIM), ('dil_k', N_HEADS_DIL * HEAD_DIM), ('dil_v', N_HEADS_DIL * HEAD_DIM),
)
D_IN = sum(w for _, w in IN_SPLITS)

kernel_name = 'hymba_style_fox_nsa_swa_dilated_macaron'


def rms_norm(x, g):
    xf = x.astype(jnp.float32)
    y = xf * lax.rsqrt(jnp.mean(xf * xf, axis=-1, keepdims=True) + RMS_EPS)
    return (y * g.astype(jnp.float32)).astype(x.dtype)


def swiglu(x, w_gate, w_up, w_down):
    return (jax.nn.silu(x @ w_gate) * (x @ w_up)) @ w_down


def split_columns(z):
    parts = {}
    off = 0
    for name, w in IN_SPLITS:
        parts[name] = z[..., off:off + w]
        off += w
    return parts


def to_heads(t, n):
    b, s, _ = t.shape
    return t.reshape(b, s, n, HEAD_DIM).transpose(0, 2, 1, 3)


def alibi_slopes():
    n = N_HEADS_SWA + N_HEADS_NSA + N_HEADS_DIL
    return jnp.asarray(2.0 ** (-8.0 * np.arange(1, n + 1) / n), jnp.float32)


def masked_softmax(s, mask):
    s = jnp.where(mask, s, -jnp.inf)
    m = jnp.max(s, axis=-1, keepdims=True)
    m = jnp.where(jnp.isfinite(m), m, 0.0)
    e = jnp.where(mask, jnp.exp(s - m), 0.0)
    return e / jnp.maximum(jnp.sum(e, axis=-1, keepdims=True), 1e-30)


def banded_attention(q, k, v, max_dist, slopes):
    b, h, l, hd = q.shape
    n_prev = -(-max_dist // BLOCK)
    nb = -(-l // BLOCK)
    pad = nb * BLOCK - l
    qb = jnp.pad(q, ((0, 0), (0, 0), (0, pad), (0, 0))).reshape(b, h, nb, BLOCK, hd)

    def windows(t):
        tp = jnp.pad(t, ((0, 0), (0, 0), (n_prev * BLOCK, pad), (0, 0))).reshape(b, h, nb + n_prev, BLOCK, hd)
        return jnp.concatenate([tp[:, :, j:j + nb] for j in range(n_prev + 1)], axis=3)

    kw, vw = windows(k), windows(v)
    width = (n_prev + 1) * BLOCK
    qpos = jnp.arange(nb)[:, None, None] * BLOCK + jnp.arange(BLOCK)[None, :, None]
    kpos = jnp.arange(nb)[:, None, None] * BLOCK + jnp.arange(width)[None, None, :] - n_prev * BLOCK
    dist = qpos - kpos
    mask = (dist >= 0) & (dist <= max_dist) & (kpos >= 0)
    s = jnp.einsum('bhnqd,bhnkd->bhnqk', qb, kw).astype(jnp.float32) * (hd ** -0.5)
    s = s - slopes.astype(jnp.float32)[:, None, None, None] * dist.astype(jnp.float32)
    s = jnp.where(mask, s, -jnp.inf)
    m = jnp.max(s, axis=-1, keepdims=True)
    e = jnp.exp(s - m)
    den = jnp.sum(e, axis=-1, keepdims=True)
    out = jnp.einsum('bhnqk,bhnkd->bhnqd', (e / den).astype(v.dtype), vw)
    lse = (m + jnp.log(den))[..., 0]
    out = out.reshape(b, h, nb * BLOCK, hd)[:, :, :l]
    lse = lse.reshape(b, h, nb * BLOCK)[:, :, :l]
    return out, lse


def forgetting_attention(q, k, v, log_f):
    b, h, s_len, hd = q.shape
    c = jnp.cumsum(log_f.astype(jnp.float32), axis=-1)
    nb = s_len // BLOCK
    qb = q.reshape(b, h, nb, BLOCK, hd).transpose(2, 0, 1, 3, 4)
    cb = c.reshape(b, h, nb, BLOCK).transpose(2, 0, 1, 3)
    kpos = jnp.arange(s_len)

    def one_block(args):
        i, q_i, c_i = args
        s = jnp.einsum('bhqd,bhkd->bhqk', q_i, k).astype(jnp.float32) * (hd ** -0.5)
        s = s + c_i[..., :, None] - c[..., None, :]
        qpos = i * BLOCK + jnp.arange(BLOCK)
        s = jnp.where(kpos[None, :] <= qpos[:, None], s, -jnp.inf)
        p = jax.nn.softmax(s, axis=-1)
        return jnp.einsum('bhqk,bhkd->bhqd', p.astype(v.dtype), v)

    out = lax.map(one_block, (jnp.arange(nb), qb, cb))
    return out.transpose(1, 2, 0, 3, 4).reshape(b, h, s_len, hd)


def nsa_attention(q, k_cmp, v_cmp, k_slc, v_slc, k_win, v_win, gate_logits, cmp_pe, cmp_w1, cmp_w2, slopes):
    b, h, s_len, hd = q.shape
    scale = hd ** -0.5
    t_pos = jnp.arange(s_len)
    sl = slopes.astype(jnp.float32)

    n_chunk = s_len // NSA_CMP_STRIDE
    n_cmp = n_chunk - 1

    def compress(t, idx):
        ch = t.reshape(b, n_chunk, NSA_CMP_STRIDE, hd)
        blocks = jnp.concatenate([ch[:, :-1], ch[:, 1:]], axis=2) + cmp_pe[idx]
        hid = jax.nn.silu(jnp.einsum('bnld,lde->bne', blocks, cmp_w1[idx]))
        return hid @ cmp_w2[idx]

    kc, vc = compress(k_cmp, 0), compress(v_cmp, 1)
    cmp_start = jnp.arange(n_cmp) * NSA_CMP_STRIDE
    cmp_dist = t_pos[:, None] - (cmp_start + NSA_CMP_LEN - 1)[None, :]
    s_cmp = jnp.einsum('bhtd,bnd->bhtn', q, kc).astype(jnp.float32) * scale
    s_cmp = s_cmp - sl[:, None, None] * cmp_dist.astype(jnp.float32)
    p_cmp = masked_softmax(s_cmp, cmp_dist >= 0)
    o_cmp = jnp.einsum('bhtn,bnd->bhtd', p_cmp.astype(vc.dtype), vc)

    n_sel = s_len // NSA_SEL_LEN
    sel_start = jnp.arange(n_sel) * NSA_SEL_LEN
    overlap = ((cmp_start[:, None] <= sel_start[None, :] + NSA_SEL_LEN - 1)
               & (cmp_start[:, None] + NSA_CMP_LEN - 1 >= sel_start[None, :])).astype(jnp.float32)
    imp = jnp.einsum('bhtn,nj->btj', p_cmp, overlap)
    cur = t_pos // NSA_SEL_LEN
    jj = jnp.arange(n_sel)
    causal_sel = sel_start[None, :] <= t_pos[:, None]
    forced = (jj[None, :] == 0) | (jj[None, :] == cur[:, None]) | (jj[None, :] == cur[:, None] - 1)
    score = jnp.where(causal_sel, jnp.where(forced, jnp.inf, imp), -jnp.inf)
    n_top = min(NSA_TOPN, n_sel)
    top_val, top_idx = lax.top_k(score, n_top)
    sel_ok = top_val > -jnp.inf

    ks_blocks = k_slc.reshape(b, n_sel, NSA_SEL_LEN, hd)
    vs_blocks = v_slc.reshape(b, n_sel, NSA_SEL_LEN, hd)
    nb = s_len // BLOCK
    qb = q.reshape(b, h, nb, BLOCK, hd).transpose(2, 0, 1, 3, 4)
    ib = top_idx.reshape(b, nb, BLOCK, n_top).transpose(1, 0, 2, 3)
    okb = sel_ok.reshape(b, nb, BLOCK, n_top).transpose(1, 0, 2, 3)
    gather = jax.vmap(lambda blocks, ix: blocks[ix])
    n_keys = n_top * NSA_SEL_LEN

    def one_block(args):
        i, q_i, idx_i, ok_i = args
        kg = gather(ks_blocks, idx_i).reshape(b, BLOCK, n_keys, hd)
        vg = gather(vs_blocks, idx_i).reshape(b, BLOCK, n_keys, hd)
        kpos = (idx_i[..., None] * NSA_SEL_LEN + jnp.arange(NSA_SEL_LEN)).reshape(b, BLOCK, n_keys)
        qpos = i * BLOCK + jnp.arange(BLOCK)
        dist = qpos[None, :, None] - kpos
        mask = (dist >= 0) & jnp.repeat(ok_i, NSA_SEL_LEN, axis=-1)
        s = jnp.einsum('bhqd,bqkd->bhqk', q_i, kg).astype(jnp.float32) * scale
        s = s - sl[None, :, None, None] * dist[:, None].astype(jnp.float32)
        p = masked_softmax(s, mask[:, None])
        return jnp.einsum('bhqk,bqkd->bhqd', p.astype(vg.dtype), vg)

    o_slc = lax.map(one_block, (jnp.arange(nb), qb, ib, okb))
    o_slc = o_slc.transpose(1, 2, 0, 3, 4).reshape(b, h, s_len, hd)

    kw = jnp.broadcast_to(k_win[:, None], (b, h, s_len, hd))
    vw = jnp.broadcast_to(v_win[:, None], (b, h, s_len, hd))
    o_win, _ = banded_attention(q, kw, vw, NSA_WINDOW - 1, slopes)

    g = jax.nn.sigmoid(gate_logits).reshape(b, s_len, h, 3).transpose(0, 2, 1, 3).astype(q.dtype)
    return g[..., 0:1] * o_cmp + g[..., 1:2] * o_slc + g[..., 2:3] * o_win


def sink_window_attention(q, k, v, sinks, slopes):
    rep = q.shape[1] // k.shape[1]
    k = jnp.repeat(k, rep, axis=1)
    v = jnp.repeat(v, rep, axis=1)
    out, lse = banded_attention(q, k, v, SWA_WINDOW - 1, slopes)
    keep = jax.nn.sigmoid(lse - sinks.astype(jnp.float32)[None, :, None])
    return out * keep[..., None].astype(out.dtype)


def dilated_attention(q, k, v, slopes):
    b, h, s_len, hd = q.shape
    outs, lses = [], []
    for window, d in DIL_PAIRS:
        def strided(t):
            return t.reshape(b, h, s_len // d, d, hd).transpose(0, 1, 3, 2, 4).reshape(b, h * d, s_len // d, hd)
        o, l = banded_attention(strided(q), strided(k), strided(v), window // d, jnp.repeat(slopes, d) * d)
        outs.append(o.reshape(b, h, d, s_len // d, hd).transpose(0, 1, 3, 2, 4).reshape(b, h, s_len, hd))
        lses.append(l.reshape(b, h, d, s_len // d).transpose(0, 1, 3, 2).reshape(b, h, s_len))
    w = jax.nn.softmax(jnp.stack(lses, axis=0), axis=0)
    return jnp.einsum('gbhs,gbhsd->bhsd', w.astype(q.dtype), jnp.stack(outs, axis=0))


def hybrid_mixer(hn, w_in, fox_b_f, nsa_cmp_pe, nsa_cmp_w1, nsa_cmp_w2, swa_sinks, w_out):
    b, s_len, _ = hn.shape
    z = split_columns(hn @ w_in)
    slopes = alibi_slopes()
    sl_swa = slopes[:N_HEADS_SWA]
    sl_nsa = slopes[N_HEADS_SWA:N_HEADS_SWA + N_HEADS_NSA]
    sl_dil = slopes[N_HEADS_SWA + N_HEADS_NSA:]

    log_f = jax.nn.log_sigmoid((z['fox_f'] + fox_b_f).astype(jnp.float32)).transpose(0, 2, 1)
    o_a = forgetting_attention(to_heads(z['fox_q'], N_HEADS_FOX), to_heads(z['fox_k'], N_HEADS_FOX),
                               to_heads(z['fox_v'], N_HEADS_FOX), log_f)
    o_b = nsa_attention(to_heads(z['nsa_q'], N_HEADS_NSA), z['nsa_k_cmp'], z['nsa_v_cmp'],
                        z['nsa_k_slc'], z['nsa_v_slc'], z['nsa_k_win'], z['nsa_v_win'], z['nsa_gate'],
                        nsa_cmp_pe, nsa_cmp_w1, nsa_cmp_w2, sl_nsa)
    o_c = sink_window_attention(to_heads(z['swa_q'], N_HEADS_SWA), to_heads(z['swa_k'], N_KV_SWA),
                                to_heads(z['swa_v'], N_KV_SWA), swa_sinks, sl_swa)
    o_d = dilated_attention(to_heads(z['dil_q'], N_HEADS_DIL), to_heads(z['dil_k'], N_HEADS_DIL),
                            to_heads(z['dil_v'], N_HEADS_DIL), sl_dil)
    o = jnp.concatenate([o_a, o_b.astype(o_a.dtype), o_c.astype(o_a.dtype), o_d.astype(o_a.dtype)], axis=1)
    o = o.transpose(0, 2, 1, 3).reshape(b, s_len, D_MIX).astype(hn.dtype)
    return o @ w_out


def setup_inputs(seed: int = 0) -> dict:
    key = jax.random.key(seed)
    ks = jax.random.split(key, 20)
    f32 = jnp.float32
    L, D, F = DEPTH, D_MODEL, D_FF

    def nrm(k, shape, scale):
        return jax.random.normal(k, shape, f32) * scale

    def gain(k, shape):
        return 1.0 + 0.02 * jax.random.normal(k, shape, f32)

    return {
        'x': nrm(ks[0], (BATCH, SEQ, D), 1.0),
        'norm_ffn1': gain(ks[1], (L, D)),
        'ffn1_w_gate': nrm(ks[2], (L, D, F), D ** -0.5),
        'ffn1_w_up': nrm(ks[3], (L, D, F), D ** -0.5),
        'ffn1_w_down': nrm(ks[4], (L, F, D), F ** -0.5),
        'norm_mix': gain(ks[5], (L, D)),
        'w_in': nrm(ks[6], (L, D, D_IN), D ** -0.5),
        'fox_b_f': 3.0 + 0.1 * jax.random.normal(ks[7], (L, N_HEADS_FOX), f32),
        'nsa_cmp_pe': nrm(ks[8], (L, 2, NSA_CMP_LEN, HEAD_DIM), 0.02),
        'nsa_cmp_w1': nrm(ks[9], (L, 2, NSA_CMP_LEN, HEAD_DIM, NSA_CMP_HIDDEN), (NSA_CMP_LEN * HEAD_DIM) ** -0.5),
        'nsa_cmp_w2': nrm(ks[10], (L, 2, NSA_CMP_HIDDEN, HEAD_DIM), NSA_CMP_HIDDEN ** -0.5),
        'swa_sinks': nrm(ks[11], (L, N_HEADS_SWA), 0.5),
        'w_out': nrm(ks[12], (L, D_MIX, D), D_MIX ** -0.5),
        'norm_ffn2': gain(ks[13], (L, D)),
        'ffn2_w_gate': nrm(ks[14], (L, D, F), D ** -0.5),
        'ffn2_w_up': nrm(ks[15], (L, D, F), D ** -0.5),
        'ffn2_w_down': nrm(ks[16], (L, F, D), F ** -0.5),
        'norm_final': gain(ks[17], (D,)),
    }


def reference(x, norm_ffn1, ffn1_w_gate, ffn1_w_up, ffn1_w_down, norm_mix, w_in, fox_b_f,
              nsa_cmp_pe, nsa_cmp_w1, nsa_cmp_w2, swa_sinks, w_out,
              norm_ffn2, ffn2_w_gate, ffn2_w_up, ffn2_w_down, norm_final):
    for l in range(DEPTH):
        x = x + 0.5 * swiglu(rms_norm(x, norm_ffn1[l]), ffn1_w_gate[l], ffn1_w_up[l], ffn1_w_down[l])
        x = x + hybrid_mixer(rms_norm(x, norm_mix[l]), w_in[l], fox_b_f[l], nsa_cmp_pe[l],
                             nsa_cmp_w1[l], nsa_cmp_w2[l], swa_sinks[l], w_out[l])
        x = x + 0.5 * swiglu(rms_norm(x, norm_ffn2[l]), ffn2_w_gate[l], ffn2_w_up[l], ffn2_w_down[l])
    return rms_norm(x, norm_final)
```

```cpp
#include <hip/hip_runtime.h>
#include <cstdio>
#include <cstdint>
#include <cmath>
namespace pg8 {
#define PG8_LAS __attribute__((address_space(3)))
typedef unsigned short bf16_t;
typedef short bf16x8 __attribute__((ext_vector_type(8)));
typedef float f32x4 __attribute__((ext_vector_type(4)));
typedef unsigned u32x4 __attribute__((ext_vector_type(4)));
constexpr int BM = 256, BK = 64, HALF = 128, HTB = HALF * BK * 2  , STAGE_BYTES = 8 * HTB, NXCD = 8, WGM = 8;

__host__ __device__ __forceinline__ int lds_byte(int r, int c) { const int st = (r >> 4) * 2 + (c >> 5), rr = r & 15, cc = c & 31, ob = rr * 64 + cc * 2; return st * 1024 + (ob ^ (((ob >> 9) & 1) << 5)); }
__host__ __device__ __forceinline__ void stage_rc(int b, int& R, int& C) { const int st = b / 1024, sb = b % 1024, swz = sb ^ (((sb >> 9) & 1) << 5); R = (st >> 1) * 16 + swz / 64; C = (st & 1) * 32 + (swz % 64) / 2; }
__host__ __device__ __forceinline__ int perm32(int rho) { const int n = rho >> 4, i = rho & 15; return 8 * (i >> 2) + 4 * n + (i & 3); }

struct Unit { int pm, pn; };
struct Gemm { const bf16_t* A; const bf16_t* Bt; int M, N, K; };

struct StaticOrder {
    int nM, nN, nwg, G, c;
    __host__ __device__ void init(int M, int N, int G_, int c_) { nM = M / BM; nN = N / BM; nwg = nM * nN; G = G_; c = c_; }
    __host__ __device__ bool next(int i, Unit& u) const {
        const long L = (long)i * G + c; if (L >= nwg) return false;
        int wgid = (int)L; { const int q = nwg / NXCD, r = nwg % NXCD, xcd = wgid % NXCD, off = wgid / NXCD; wgid = (xcd < r ? xcd * (q + 1) : r * (q + 1) + (xcd - r) * q) + off; }
        const int nig = WGM * nN, gid = wgid / nig, fm = gid * WGM, gsz = (nM - fm) < WGM ? (nM - fm) : WGM;
        u.pm = fm + ((wgid % nig) % gsz); u.pn = (wgid % nig) / gsz; return true;
    }
    __device__ __forceinline__ void a_ready(const Unit&) const {}
    __device__ __forceinline__ void done(const Unit&) const {}
};

__device__ __forceinline__ unsigned cvt_pk_bf16(float lo, float hi) { unsigned r; asm volatile("v_cvt_pk_bf16_f32 %0, %1, %2" : "=v"(r) : "v"(lo), "v"(hi)); return r; }
typedef float f32x2 __attribute__((ext_vector_type(2)));
constexpr float RMS_EPS_F = 1e-6f;
typedef unsigned u32x2 __attribute__((ext_vector_type(2)));
__device__ __forceinline__ float row_rstd(const float* ssq, int row, int fq) {
    const f32x4 p = *(const f32x4*)(ssq + (size_t)row * 16 + 4 * fq);
    float s = (p[0] + p[1]) + (p[2] + p[3]);
    s += __shfl_xor(s, 16); s += __shfl_xor(s, 32);
    return 1.0f / sqrtf(s * (1.0f / 1024.0f) + RMS_EPS_F);
}
__device__ __forceinline__ void row_rstd8(float (&rs)[2][4], const float* ssq, int row0, int fq) {
    f32x4 p[2][4];
#pragma unroll
    for (int ai = 0; ai < 2; ++ai)
#pragma unroll
        for (int m = 0; m < 4; ++m) p[ai][m] = *(const f32x4*)(ssq + (size_t)(row0 + ai * HALF + m * 16) * 16 + 4 * fq);
#pragma unroll
    for (int ai = 0; ai < 2; ++ai)
#pragma unroll
        for (int m = 0; m < 4; ++m) { float s = (p[ai][m][0] + p[ai][m][1]) + (p[ai][m][2] + p[ai][m][3]); s += __shfl_xor(s, 16); s += __shfl_xor(s, 32); rs[ai][m] = 1.0f / sqrtf(s * (1.0f / 1024.0f) + RMS_EPS_F); }
}
__device__ __forceinline__ float silu_mul(float g, float u) { return g * u * __builtin_amdgcn_rcpf(1.0f + __expf(-g)); }
struct EpiSwiglu {
    static constexpr bool PERM = true, AFTER_DRAIN = false;
    bf16_t* H; const float* ssq; int ldh;
    __device__ __forceinline__ void operator()(const f32x4 (&acc)[2][2][4][2], const Unit& u, int wr, int wc, int fr, int fq) const {
        const int row0 = u.pm * BM + wr * 64 + fr; const int col0 = u.pn * HALF + wc * 32 + 8 * fq;
        float rsv[2][4]; row_rstd8(rsv, ssq, row0, fq);
#pragma unroll
        for (int ai = 0; ai < 2; ++ai)
#pragma unroll
            for (int m = 0; m < 4; ++m) {
                const int row = row0 + ai * HALF + m * 16; const float rs = rsv[ai][m];
                const f32x4 g0 = acc[ai][0][m][0] * rs, g1 = acc[ai][0][m][1] * rs, u0 = acc[ai][1][m][0] * rs, u1 = acc[ai][1][m][1] * rs;
                u32x4 w; w.x = cvt_pk_bf16(silu_mul(g0[0], u0[0]), silu_mul(g0[1], u0[1])); w.y = cvt_pk_bf16(silu_mul(g0[2], u0[2]), silu_mul(g0[3], u0[3]));
                w.z = cvt_pk_bf16(silu_mul(g1[0], u1[0]), silu_mul(g1[1], u1[1])); w.w = cvt_pk_bf16(silu_mul(g1[2], u1[2]), silu_mul(g1[3], u1[3]));
                *(u32x4*)(H + (size_t)row * ldh + col0) = w;
            }
    }
};
struct EpiResid {
    static constexpr bool PERM = true, AFTER_DRAIN = false;
    const float* base; float* xout; bf16_t* XG; const float* gnext; float* ssq; float alpha;
    __device__ __forceinline__ void operator()(const f32x4 (&acc)[2][2][4][2], const Unit& u, int wr, int wc, int fr, int fq) const {
        const int row0 = u.pm * BM + wr * 64 + fr; const int col0 = u.pn * BM + wc * 32 + 8 * fq;
        f32x4 gv[2][2];
#pragma unroll
        for (int bj = 0; bj < 2; ++bj)
#pragma unroll
            for (int n = 0; n < 2; ++n) gv[bj][n] = *(const f32x4*)(gnext + col0 + bj * HALF + 4 * n);
#pragma unroll
        for (int ai = 0; ai < 2; ++ai)
#pragma unroll
            for (int m = 0; m < 4; ++m) {
                const int row = row0 + ai * HALF + m * 16; float ss = 0.f;
#pragma unroll
                for (int bj = 0; bj < 2; ++bj) {
                    const size_t off = (size_t)row * 1024 + col0 + bj * HALF;
                    const f32x4 b0 = *(const f32x4*)(base + off), b1 = *(const f32x4*)(base + off + 4);
                    const f32x4 v0 = b0 + acc[ai][bj][m][0] * alpha, v1 = b1 + acc[ai][bj][m][1] * alpha;
                    *(f32x4*)(xout + off) = v0; *(f32x4*)(xout + off + 4) = v1;
                    ss += (v0[0] * v0[0] + v0[1] * v0[1]) + (v0[2] * v0[2] + v0[3] * v0[3]) + (v1[0] * v1[0] + v1[1] * v1[1]) + (v1[2] * v1[2] + v1[3] * v1[3]);
                    const f32x4 y0 = v0 * gv[bj][0], y1 = v1 * gv[bj][1];
                    u32x4 w; w.x = cvt_pk_bf16(y0[0], y0[1]); w.y = cvt_pk_bf16(y0[2], y0[3]); w.z = cvt_pk_bf16(y1[0], y1[1]); w.w = cvt_pk_bf16(y1[2], y1[3]);
                    *(u32x4*)(XG + off) = w;
                }
                ss += __shfl_xor(ss, 16); ss += __shfl_xor(ss, 32);
                if (fq == 0) ssq[(size_t)row * 16 + u.pn * 4 + wc] = ss;
                if (m & 1) asm volatile("" ::: "memory");
            }
    }
};
struct EpiZ {
    static constexpr bool PERM = true, AFTER_DRAIN = false;
    bf16_t* Z; float* ZS; const float* ssq; int ldz;
    __device__ __forceinline__ void operator()(const f32x4 (&acc)[2][2][4][2], const Unit& u, int wr, int wc, int fr, int fq) const {
        const int row0 = u.pm * BM + wr * 64 + fr; const int col0 = u.pn * BM + wc * 32 + 8 * fq;
        const bool small = (u.pn == 10) && (wc == 0) && (fq < 2);
        float rsv[2][4]; row_rstd8(rsv, ssq, row0, fq);
#pragma unroll
        for (int ai = 0; ai < 2; ++ai)
#pragma unroll
            for (int m = 0; m < 4; ++m) {
                const int row = row0 + ai * HALF + m * 16; const float rs = rsv[ai][m];
#pragma unroll
                for (int bj = 0; bj < 2; ++bj) {
                    const f32x4 v0 = acc[ai][bj][m][0] * rs, v1 = acc[ai][bj][m][1] * rs;
                    u32x4 w; w.x = cvt_pk_bf16(v0[0], v0[1]); w.y = cvt_pk_bf16(v0[2], v0[3]); w.z = cvt_pk_bf16(v1[0], v1[1]); w.w = cvt_pk_bf16(v1[2], v1[3]);
                    *(u32x4*)(Z + (size_t)row * ldz + col0 + bj * HALF) = w;
                    if (bj == 1 && small) { *(f32x4*)(ZS + (size_t)row * 16 + 8 * fq) = v0; *(f32x4*)(ZS + (size_t)row * 16 + 8 * fq + 4) = v1; }
                }
            }
    }
};
template <class Epi, class Sched, bool ALIGN_EPI = false, bool SP2 = false>
__device__ __forceinline__ void gemm_phase(PG8_LAS unsigned char* lds, const Gemm g, const Sched& S, const Epi& E) {
    int tid_ = threadIdx.x; asm volatile("" : "+v"(tid_));
    const int tid = tid_, wid = __builtin_amdgcn_readfirstlane(tid >> 6), lane = tid & 63, wr = wid >> 2, wc = wid & 3, fr = lane & 15, fq = lane >> 4;
    const int K = g.K, nt = K / BK;
    unsigned voffA[2], voffB[2];
#pragma unroll
    for (int i = 0; i < 2; ++i) { int R, C; stage_rc(tid * 16 + i * 8192, R, C); const int Rb = Epi::PERM ? ((R & ~31) + perm32(R & 31)) : R;
        voffA[i] = (unsigned)(R * K + C) * 2u; voffB[i] = (unsigned)(Rb * K + C) * 2u; }
    const size_t kstep = (size_t)(BK * 2);
    const size_t hstep = (size_t)HALF * K * 2;
    const size_t tstep = 2 * hstep;
    const unsigned ldsw = (unsigned)wid * 1024u;
    const int aoff = lds_byte(wr * 64 + fr, fq * 8), boff = lds_byte(wc * 32 + fr, fq * 8);
#define PG8_SA(b, h) (((b) * 2 + (h)) * HTB)
#define PG8_SB(b, h) ((4 + (b) * 2 + (h)) * HTB)
#define PG8_STAGE(bufoff, gbase, voff) do { _Pragma("unroll") for (int _i = 0; _i < 2; ++_i) \
        __builtin_amdgcn_global_load_lds((const unsigned*)((const char*)(gbase) + (voff)[_i]), (PG8_LAS unsigned*)(lds + (bufoff) + ldsw + _i * 8192), 16, 0, 0); } while (0)
#define PG8_LDA(dst, b, h) do { _Pragma("unroll") for (int m = 0; m < 4; ++m) _Pragma("unroll") for (int k = 0; k < 2; ++k) dst[m][k] = *(const PG8_LAS bf16x8*)(lds + PG8_SA(b, h) + aoff + m * 2048 + k * 1024); } while (0)
#define PG8_LDB(dst, b, h) do { _Pragma("unroll") for (int n = 0; n < 2; ++n) _Pragma("unroll") for (int k = 0; k < 2; ++k) dst[n][k] = *(const PG8_LAS bf16x8*)(lds + PG8_SB(b, h) + boff + n * 2048 + k * 1024); } while (0)
#define PG8_MMA(ai, bj, At, Bt) do { __builtin_amdgcn_s_setprio(1); _Pragma("unroll") for (int m = 0; m < 4; ++m) _Pragma("unroll") for (int n = 0; n < 2; ++n) _Pragma("unroll") for (int k = 0; k < 2; ++k) \
        acc[ai][bj][m][n] = __builtin_amdgcn_mfma_f32_16x16x32_bf16(Bt[n][k], At[m][k], acc[ai][bj][m][n], 0, 0, 0); __builtin_amdgcn_s_setprio(0); } while (0)
#define PG8_WAIT_V(n) asm volatile("s_waitcnt vmcnt(" #n ")" ::: "memory")
#define PG8_WAIT_L(n) asm volatile("s_waitcnt lgkmcnt(" #n ")" ::: "memory")
#define PG8_BAR __builtin_amdgcn_s_barrier()
#define PG8_SCHED __builtin_amdgcn_sched_barrier(0)
    Unit cur, nxt; int ui = 0;
    if (!S.next(0, cur)) return;
    f32x4 acc[2][2][4][2];
#pragma unroll
    for (int a = 0; a < 2; ++a)
#pragma unroll
        for (int b = 0; b < 2; ++b)
#pragma unroll
            for (int m = 0; m < 4; ++m)
#pragma unroll
                for (int n = 0; n < 2; ++n) acc[a][b][m][n] = (f32x4){0.f, 0.f, 0.f, 0.f};
    bf16x8 At[4][2], B0[2][2], B1[2][2];
    const char* cA = (const char*)g.A + (size_t)cur.pm * tstep; const char* cB = (const char*)g.Bt + (size_t)cur.pn * tstep;
    S.a_ready(cur);
    if constexpr (SP2) {
        PG8_STAGE(PG8_SB(0, 0), cB, voffB); PG8_STAGE(PG8_SB(0, 1), cB + hstep, voffB); PG8_STAGE(PG8_SA(0, 0), cA, voffA); PG8_STAGE(PG8_SA(0, 1), cA + hstep, voffA);
        if (wr == 1) PG8_BAR;
        PG8_WAIT_V(2); PG8_BAR;
        PG8_STAGE(PG8_SB(1, 0), cB + kstep, voffB); PG8_STAGE(PG8_SA(1, 0), cA + kstep, voffA); PG8_STAGE(PG8_SB(1, 1), cB + hstep + kstep, voffB);
        PG8_WAIT_V(6); PG8_BAR;
    } else {
        PG8_STAGE(PG8_SB(0, 0), cB, voffB); PG8_STAGE(PG8_SA(0, 0), cA, voffA); PG8_STAGE(PG8_SB(0, 1), cB + hstep, voffB); PG8_STAGE(PG8_SA(0, 1), cA + hstep, voffA);
        if (wr == 1) PG8_BAR;
        PG8_WAIT_V(4); PG8_BAR;
        PG8_STAGE(PG8_SB(1, 0), cB + kstep, voffB); PG8_STAGE(PG8_SA(1, 0), cA + kstep, voffA); PG8_STAGE(PG8_SB(1, 1), cB + hstep + kstep, voffB);
        PG8_WAIT_V(6); PG8_BAR;
    }
    for (;;) {
        const bool has_next = S.next(ui + 1, nxt);
        const char* nA = has_next ? (const char*)g.A + (size_t)nxt.pm * tstep : cA; const char* nB = has_next ? (const char*)g.Bt + (size_t)nxt.pn * tstep : cB;
        for (int t = 0; t < nt; t += 2) {
            const bool last = (t == nt - 2);
            const char* a1 = cA + (size_t)(t + 1) * kstep;
            const char* a2 = last ? nA : cA + (size_t)(t + 2) * kstep; const char* b2 = last ? nB : cB + (size_t)(t + 2) * kstep;
            const char* a3 = a2 + kstep; const char* b3 = b2 + kstep;
            if (last && has_next) S.a_ready(nxt);
            if constexpr (SP2) {
            PG8_LDB(B0, 0, 0); PG8_LDB(B1, 0, 1); PG8_SCHED; PG8_LDA(At, 0, 0); PG8_STAGE(PG8_SA(1, 1), a1 + hstep, voffA);
            PG8_WAIT_V(8); PG8_WAIT_L(0); PG8_BAR; PG8_MMA(0, 0, At, B0); PG8_MMA(0, 1, At, B1); PG8_BAR; PG8_SCHED;
            PG8_LDA(At, 0, 1); PG8_STAGE(PG8_SB(0, 0), b2, voffB); PG8_STAGE(PG8_SB(0, 1), b2 + hstep, voffB); PG8_STAGE(PG8_SA(0, 0), a2, voffA);
            PG8_WAIT_V(8); PG8_WAIT_L(0); PG8_BAR; PG8_MMA(1, 0, At, B0); PG8_MMA(1, 1, At, B1); PG8_BAR; PG8_SCHED;
            PG8_LDB(B0, 1, 0); PG8_LDB(B1, 1, 1); PG8_SCHED; PG8_LDA(At, 1, 0); PG8_STAGE(PG8_SA(0, 1), a2 + hstep, voffA);
            PG8_WAIT_V(8); PG8_WAIT_L(0); PG8_BAR; PG8_MMA(0, 0, At, B0); PG8_MMA(0, 1, At, B1); PG8_BAR; PG8_SCHED;
            PG8_LDA(At, 1, 1); PG8_STAGE(PG8_SB(1, 0), b3, voffB); PG8_STAGE(PG8_SB(1, 1), b3 + hstep, voffB); PG8_STAGE(PG8_SA(1, 0), a3, voffA);
            PG8_WAIT_V(8); PG8_WAIT_L(0); PG8_BAR; PG8_MMA(1, 0, At, B0); PG8_MMA(1, 1, At, B1); PG8_BAR; PG8_SCHED;
            } else {
            PG8_LDB(B0, 0, 0); PG8_SCHED; PG8_LDA(At, 0, 0); PG8_STAGE(PG8_SA(1, 1), a1 + hstep, voffA);
            PG8_WAIT_L(8); PG8_BAR; PG8_WAIT_L(0); PG8_MMA(0, 0, At, B0); PG8_BAR; PG8_SCHED;
            PG8_LDB(B1, 0, 1); PG8_STAGE(PG8_SB(0, 0), b2, voffB);
            PG8_BAR; PG8_WAIT_L(0); PG8_MMA(0, 1, At, B1); PG8_BAR;
            PG8_LDA(At, 0, 1); PG8_STAGE(PG8_SA(0, 0), a2, voffA);
            PG8_BAR; PG8_WAIT_L(0); PG8_MMA(1, 0, At, B0); PG8_BAR; PG8_SCHED;
            PG8_STAGE(PG8_SB(0, 1), b2 + hstep, voffB);
            PG8_WAIT_V(6); PG8_BAR; PG8_MMA(1, 1, At, B1); PG8_BAR;
            PG8_LDB(B0, 1, 0); PG8_SCHED; PG8_LDA(At, 1, 0); PG8_STAGE(PG8_SA(0, 1), a2 + hstep, voffA);
            PG8_WAIT_L(8); PG8_BAR; PG8_WAIT_L(0); PG8_MMA(0, 0, At, B0); PG8_BAR; PG8_SCHED;
            PG8_LDB(B1, 1, 1); PG8_STAGE(PG8_SB(1, 0), b3, voffB);
            PG8_BAR; PG8_WAIT_L(0); PG8_MMA(0, 1, At, B1); PG8_BAR;
            PG8_LDA(At, 1, 1); PG8_STAGE(PG8_SA(1, 0), a3, voffA);
            PG8_BAR; PG8_WAIT_L(0); PG8_MMA(1, 0, At, B0); PG8_BAR; PG8_SCHED;
            PG8_STAGE(PG8_SB(1, 1), b3 + hstep, voffB);
            PG8_WAIT_V(6); PG8_BAR; PG8_MMA(1, 1, At, B1); PG8_BAR;
            }
        }
        if constexpr (ALIGN_EPI) { if (wr == 0) PG8_BAR; }
        if constexpr (!Epi::AFTER_DRAIN) { E(acc, cur, wr, wc, fr, fq); S.done(cur); }
        if (!has_next) break;
#pragma unroll
        for (int a = 0; a < 2; ++a)
#pragma unroll
            for (int b = 0; b < 2; ++b)
#pragma unroll
                for (int m = 0; m < 4; ++m)
#pragma unroll
                    for (int n = 0; n < 2; ++n) acc[a][b][m][n] = (f32x4){0.f, 0.f, 0.f, 0.f};
        cur = nxt; cA = nA; cB = nB; ++ui;
        if constexpr (ALIGN_EPI) { if (wr == 1) PG8_BAR; }
    }
    PG8_WAIT_V(0);
    if constexpr (!ALIGN_EPI) { if (wr == 0) PG8_BAR; }
    PG8_BAR;
    if constexpr (Epi::AFTER_DRAIN) { E.fused(acc, cur, wr, wc, fr, fq, lds, wid, lane); S.done(cur); }
#undef PG8_SA
#undef PG8_SB
#undef PG8_STAGE
#undef PG8_LDA
#undef PG8_LDB
#undef PG8_MMA
#undef PG8_WAIT_V
#undef PG8_WAIT_L
#undef PG8_BAR
#undef PG8_SCHED
}
}
#include <hip/hip_cooperative_groups.h>
namespace cg = cooperative_groups;
#define LAS __attribute__((address_space(3)))
typedef unsigned short bf16;
typedef float f32x4 __attribute__((ext_vector_type(4)));
typedef unsigned v4u __attribute__((ext_vector_type(4)));

constexpr int BATCH = 8, SEQ = 4096, DM = 1024, M = BATCH * SEQ, DFF = 2816, DIN = 2704, ZP = 2816, NGU = 2 * DFF, DEPTH = 2;
constexpr int NTHR = 512, NWAVES = 8;
constexpr int ZQ_FOX = 0, ZK_FOX = 256, ZV_FOX = 512, ZQ_NSA = 768, ZKC = 1024, ZVC = 1088, ZKS = 1152, ZVS = 1216, ZKW = 1280, ZVW = 1344,
              ZQ_SWA = 1408, ZK_SWA = 1664, ZV_SWA = 1792, ZQ_DIL = 1920, ZK_DIL = 2176, ZV_DIL = 2432, ZSMALL = 2688;
constexpr size_t MiB = 1u << 20;
constexpr size_t SZ_WGU = (size_t)NGU * DM * 2, SZ_WD = (size_t)DM * DFF * 2, SZ_WIN = (size_t)ZP * DM * 2, SZ_WOUT = (size_t)DM * DM * 2;
constexpr size_t OFF_WGU1 = 0, OFF_WD1 = OFF_WGU1 + SZ_WGU, OFF_WIN = OFF_WD1 + SZ_WD, OFF_WOUT = OFF_WIN + SZ_WIN, OFF_WGU2 = OFF_WOUT + SZ_WOUT, OFF_WD2 = OFF_WGU2 + SZ_WGU, LAYER_W = 43 * MiB;
static_assert(OFF_WD2 + SZ_WD <= LAYER_W, "weights per layer");
constexpr size_t WS_W = 0, WS_ZH = 86 * MiB, WS_XG = WS_ZH + 176 * MiB, WS_O = WS_XG + 64 * MiB, WS_DO = WS_O + 64 * MiB, WS_OC = WS_DO + 48 * MiB, WS_SM = WS_OC + 32 * MiB;
constexpr size_t WS_SSQ = WS_SM, WS_ZS = WS_SSQ + 2 * MiB, WS_CUM = WS_ZS + 2 * MiB, WS_KC = WS_CUM + 1 * MiB, WS_VC = WS_KC + 1 * MiB, WS_MASK = WS_VC + 1 * MiB, WS_DL = WS_MASK + 1 * MiB, WS_END = WS_DL + 2 * MiB;
static_assert((size_t)M * ZP * 2 <= 176 * MiB && WS_END <= 512 * MiB, "ws map");
constexpr size_t WS_W1T = WS_W + LAYER_W + OFF_WD2 + SZ_WD;
static_assert(OFF_WD2 + SZ_WD + 2 * MiB <= LAYER_W, "W1T fits behind layer 1's weights");
constexpr int LDS_BYTES = 147456;
#ifndef GSEL
#define GSEL 31
#endif
#ifndef REP_P4
#define REP_P4 1
#endif
#ifndef REP_P5
#define REP_P5 1
#endif
#ifndef REP_P6
#define REP_P6 1
#endif
#ifndef REP_G1
#define REP_G1 1
#endif


#ifndef REP_CPASS
#define REP_CPASS 1
#endif
#ifndef REP_CTOPK
#define REP_CTOPK 1
#endif
#ifndef REP_PRO
#define REP_PRO 1
#endif
#ifndef REP_FOX
#define REP_FOX 1
#endif
#ifndef REP_CMP
#define REP_CMP 1
#endif
#ifndef REP_DIL
#define REP_DIL 1
#endif
#ifndef FA_FOX
#define FA_FOX 1
#endif
#ifndef FA_CMP
#define FA_CMP 1
#endif
#ifndef FA_SWA
#define FA_SWA 1
#endif
#ifndef FA_DIL
#define FA_DIL 1
#endif
#ifndef FA_NSA
#define FA_NSA 1
#endif

struct Args { const float* in[18]; float* out; unsigned char* ws; };
typedef const __attribute__((address_space(4))) Args* CArgsP;

__device__ __forceinline__ unsigned f2bf(float f) { unsigned u = __builtin_bit_cast(unsigned, f); return (u + 0x7fffu + ((u >> 16) & 1u)) >> 16; }
__device__ __forceinline__ unsigned pk2(float lo, float hi) { return f2bf(lo) | (f2bf(hi) << 16); }
__device__ __forceinline__ float bflo(unsigned w) { return __uint_as_float(w << 16); }
__device__ __forceinline__ float bfhi(unsigned w) { return __uint_as_float(w & 0xffff0000u); }
__device__ __forceinline__ float wave_sum(float v) {
#pragma unroll
    for (int o = 1; o < 64; o <<= 1) v += __shfl_xor(v, o);
    return v;
}
__device__ __forceinline__ float sigmoidf_(float x) { return 1.0f / (1.0f + __expf(-x)); }

__device__ __forceinline__ void tr_item(const float* srcp, int N, int k0, bf16* dstblk, int K, LAS float* scr, int lane) {
    float v[32];
#pragma unroll
    for (int i = 0; i < 32; ++i) { const int kk = 2 * i + (lane >> 5); v[i] = srcp ? srcp[(size_t)(k0 + kk) * N] : 0.f; }
#pragma unroll
    for (int i = 0; i < 32; ++i) { const int kk = 2 * i + (lane >> 5); scr[kk * 33 + (lane & 31)] = v[i]; }
    asm volatile("s_waitcnt lgkmcnt(0)" ::: "memory");
    const int c = lane & 7;
#pragma unroll
    for (int j = 0; j < 4; ++j) { const int n = (lane >> 3) + 8 * j; const LAS float* s = scr + (8 * c) * 33 + n;
        v4u o; o.x = pk2(s[0 * 33], s[1 * 33]); o.y = pk2(s[2 * 33], s[3 * 33]); o.z = pk2(s[4 * 33], s[5 * 33]); o.w = pk2(s[6 * 33], s[7 * 33]);
        *(v4u*)(dstblk + (size_t)n * K + 8 * c) = o; }
    asm volatile("s_waitcnt lgkmcnt(0)" ::: "memory");
}
__device__ __forceinline__ int win_src_col(int r) {
    if (r < 768) return r;
    if (r < 1408) return r + 4;
    if (r < 2688) return r + 16;
    if (r < 2692) return 768 + (r - 2688);
    if (r < 2704) return 1412 + (r - 2692);
    return -1;
}
__device__ __forceinline__ void prologue(CArgsP a, LAS unsigned char* lds, int gw, int NGW, int wave, int lane) {
    LAS float* scr = (LAS float*)(lds + wave * 16384);
    constexpr int I_GU = (DM / 64) * (NGU / 32), I_D = (DFF / 64) * (DM / 32), I_IN = (DM / 64) * (ZP / 32), I_OUT = (DM / 64) * (DM / 32);
    constexpr int I_LAYER = 2 * I_GU + 2 * I_D + I_IN + I_OUT;
    for (int it = gw; it < DEPTH * I_LAYER; it += NGW) {
        const int l = it / I_LAYER; int r = it % I_LAYER;
        unsigned char* wl = a->ws + WS_W + (size_t)l * LAYER_W;
        if (r < 2 * I_GU) {
            const int f = r / I_GU; r %= I_GU; const int nblk = NGU / 32, kb = r / nblk, nb = r % nblk, d0 = nb * 32;
            const int tile = d0 / 256, within = d0 % 256; const bool up = within >= 128; const int c0 = tile * 128 + (within & 127);
            const float* W = a->in[f == 0 ? (up ? 3 : 2) : (up ? 15 : 14)] + (size_t)l * DM * DFF;
            bf16* WT = (bf16*)(wl + (f == 0 ? OFF_WGU1 : OFF_WGU2));
            tr_item(W + c0 + (lane & 31), DFF, kb * 64, WT + (size_t)d0 * DM + kb * 64, DM, scr, lane);
            continue;
        }
        r -= 2 * I_GU;
        if (r < 2 * I_D) {
            const int f = r / I_D; r %= I_D; const int nblk = DM / 32, kb = r / nblk, nb = r % nblk, d0 = nb * 32;
            const float* W = a->in[f == 0 ? 4 : 16] + (size_t)l * DFF * DM;
            bf16* WT = (bf16*)(wl + (f == 0 ? OFF_WD1 : OFF_WD2));
            tr_item(W + d0 + (lane & 31), DM, kb * 64, WT + (size_t)d0 * DFF + kb * 64, DFF, scr, lane);
            continue;
        }
        r -= 2 * I_D;
        if (r < I_IN) {
            const int nblk = ZP / 32, kb = r / nblk, nb = r % nblk, d0 = nb * 32;
            const int sc = win_src_col(d0 + (lane & 31));
            const float* W = a->in[6] + (size_t)l * DM * DIN;
            tr_item(sc >= 0 ? W + sc : nullptr, DIN, kb * 64, (bf16*)(wl + OFF_WIN) + (size_t)d0 * DM + kb * 64, DM, scr, lane);
            continue;
        }
        r -= I_IN;
        {
            const int nblk = DM / 32, kb = r / nblk, nb = r % nblk, d0 = nb * 32;
            const float* W = a->in[12] + (size_t)l * DM * DM;
            tr_item(W + d0 + (lane & 31), DM, kb * 64, (bf16*)(wl + OFF_WOUT) + (size_t)d0 * DM + kb * 64, DM, scr, lane);
        }
    }
    for (int it = gw; it < 4 * 128; it += NGW) {
        const int li = it >> 7, r = it & 127, kb = r >> 2, d0 = (r & 3) * 32;
        tr_item(a->in[9] + (size_t)li * 2048 * 128 + d0 + (lane & 31), 128, kb * 64, (bf16*)(a->ws + WS_W1T) + ((size_t)li * 128 + d0) * 2048 + kb * 64, 2048, scr, lane);
    }
    const float* x = a->in[0]; const float* g = a->in[1]; bf16* XG = (bf16*)(a->ws + WS_XG); float* SSQ = (float*)(a->ws + WS_SSQ);
    f32x4 gv[4];
#pragma unroll
    for (int j = 0; j < 4; ++j) gv[j] = *(const f32x4*)(g + 4 * lane + 256 * j);
    for (int m = gw; m < M; m += NGW) {
        const f32x4* xr = (const f32x4*)(x + (size_t)m * DM) + lane; float s = 0.f; f32x4 v[4];
#pragma unroll
        for (int j = 0; j < 4; ++j) { v[j] = xr[64 * j]; s += (v[j][0] * v[j][0] + v[j][1] * v[j][1]) + (v[j][2] * v[j][2] + v[j][3] * v[j][3]); }
        s = wave_sum(s);
        unsigned long long* o8 = (unsigned long long*)(XG + (size_t)m * DM) + lane;
#pragma unroll
        for (int j = 0; j < 4; ++j) { const f32x4 y = v[j] * gv[j]; o8[64 * j] = (unsigned long long)pk2(y[0], y[1]) | ((unsigned long long)pk2(y[2], y[3]) << 32); }
        if (lane < 16) SSQ[(size_t)m * 16 + lane] = lane == 0 ? s : 0.f;
    }
}

struct NAcc { float m, l; float o[32]; };
__device__ __forceinline__ void nacc_init(NAcc& a) { a.m = -INFINITY; a.l = 0.f;
#pragma unroll
    for (int d = 0; d < 32; ++d) a.o[d] = 0.f; }
__device__ __forceinline__ void load_q(unsigned (&q)[16], const bf16* p) {
    const v4u* p4 = (const v4u*)p;
#pragma unroll
    for (int i = 0; i < 4; ++i) { const v4u w = p4[i]; q[4 * i] = w.x; q[4 * i + 1] = w.y; q[4 * i + 2] = w.z; q[4 * i + 3] = w.w; }
}
__device__ __forceinline__ float dot32(const unsigned (&q)[16], const bf16* krow) {
    const v4u* p4 = (const v4u*)krow; float s0 = 0.f, s1 = 0.f;
#pragma unroll
    for (int i = 0; i < 4; ++i) { const v4u w = p4[i];
        s0 += bflo(q[4 * i]) * bflo(w.x); s1 += bfhi(q[4 * i]) * bfhi(w.x); s0 += bflo(q[4 * i + 1]) * bflo(w.y); s1 += bfhi(q[4 * i + 1]) * bfhi(w.y);
        s0 += bflo(q[4 * i + 2]) * bflo(w.z); s1 += bfhi(q[4 * i + 2]) * bfhi(w.z); s0 += bflo(q[4 * i + 3]) * bflo(w.w); s1 += bfhi(q[4 * i + 3]) * bfhi(w.w); }
    float s = s0 + s1; s += __shfl_xor(s, 1); return s;
}
__device__ __forceinline__ void axpy32(float (&o)[32], float p, const bf16* vrow) {
    const v4u* p4 = (const v4u*)vrow;
#pragma unroll
    for (int i = 0; i < 4; ++i) { const v4u w = p4[i];
        o[8 * i + 0] += p * bflo(w.x); o[8 * i + 1] += p * bfhi(w.x); o[8 * i + 2] += p * bflo(w.y); o[8 * i + 3] += p * bfhi(w.y);
        o[8 * i + 4] += p * bflo(w.z); o[8 * i + 5] += p * bfhi(w.z); o[8 * i + 6] += p * bflo(w.w); o[8 * i + 7] += p * bfhi(w.w); }
}
__device__ __forceinline__ void attend1(const unsigned (&q)[16], NAcc& a, const bf16* krow, const bf16* vrow, bool valid, float bias) {
    const float dq = dot32(q, krow);
    const float s = valid ? dq * 0.125f + bias : -INFINITY;
    asm volatile("" ::: "memory");
    const float mn = fmaxf(a.m, s);
    if (__any(valid)) {
        const float ms = (mn == -INFINITY) ? 0.f : mn;
        const float alpha = __expf(a.m - ms), p = __expf(s - ms);
        if (__any(mn > a.m)) {
#pragma unroll
            for (int d = 0; d < 32; ++d) a.o[d] *= alpha;
        }
        a.l = a.l * alpha + p; a.m = mn;
        axpy32(a.o, p, vrow);
    }
    asm volatile("" ::: "memory");
}
__device__ __forceinline__ void store_o_bf16(bf16* dst, const float (&o)[32], float sc) {
    v4u* p4 = (v4u*)dst;
#pragma unroll
    for (int i = 0; i < 4; ++i) { v4u w; w.x = pk2(o[8 * i] * sc, o[8 * i + 1] * sc); w.y = pk2(o[8 * i + 2] * sc, o[8 * i + 3] * sc);
        w.z = pk2(o[8 * i + 4] * sc, o[8 * i + 5] * sc); w.w = pk2(o[8 * i + 6] * sc, o[8 * i + 7] * sc); p4[i] = w; }
}
__device__ __forceinline__ float alibi_slope(int i) { return exp2f(-8.0f * (float)(i + 1) / 12.0f); }

__device__ __forceinline__ void banded(const unsigned (&q)[16], NAcc& a, const bf16* Kb, const bf16* Vb, size_t stride, int i0s, int qi, int maxd, float slope) {
    int klo = i0s - maxd; if (klo < 0) klo = 0; const int khi = i0s + 31;
#pragma unroll 1
    for (int k = klo; k <= khi; ++k) {
        const int dist = qi - k;
        attend1(q, a, Kb + (size_t)k * stride, Vb + (size_t)k * stride, dist >= 0 && dist <= maxd, -slope * (float)dist);
    }
}

__device__ __forceinline__ void p4_cumsum(CArgsP a, int l, LAS unsigned char* lds, int bh) {
    int tid = threadIdx.x; asm volatile("" : "+v"(tid)); const int b = bh >> 2, h = bh & 3;
    const float* ZS = (const float*)(a->ws + WS_ZS); float* CUM = (float*)(a->ws + WS_CUM);
    const float bf = a->in[7][l * 4 + h];
    LAS float* part = (LAS float*)lds;
    float v[8]; float s = 0.f;
#pragma unroll
    for (int i = 0; i < 8; ++i) { const int t = tid * 8 + i; const float x = ZS[(size_t)(b * SEQ + t) * 16 + h] + bf;
        const float ls = fminf(x, 0.f) - log1pf(__expf(-fabsf(x))); s += ls; v[i] = s; }
    float incl = s;
#pragma unroll
    for (int o = 1; o < 64; o <<= 1) { const float t = __shfl_up(incl, o); if ((tid & 63) >= o) incl += t; }
    if ((tid & 63) == 63) part[tid >> 6] = incl;
    __syncthreads();
    float woff = 0.f;
    for (int w = 0; w < (tid >> 6); ++w) woff += part[w];
    const float off = woff + incl - s;
#pragma unroll
    for (int i = 0; i < 8; ++i) { const float cv = v[i] + off; CUM[(size_t)bh * SEQ + tid * 8 + i] = cv;
        const float x = -8.0f * cv; const unsigned h1 = f2bf(x); const float r1 = x - __uint_as_float(h1 << 16); const unsigned h2 = f2bf(r1); const float r2 = r1 - __uint_as_float(h2 << 16); const unsigned h3 = f2bf(r2);
        *(v4u*)(a->ws + WS_W + OFF_WD2 + SZ_WD + ((size_t)bh * SEQ + tid * 8 + i) * 16) = (v4u){h1 | (h2 << 16), h3, 0u, 0u}; }
    __syncthreads();
}
__device__ __forceinline__ void p4_compress(CArgsP a, int l, LAS unsigned char* lds, int item) {
    typedef short bf16x8c __attribute__((ext_vector_type(8)));
    int tid = threadIdx.x; asm volatile("" : "+v"(tid)); const int g = item & 15, b = (item >> 4) & 7, idx = item >> 7;
    const int wave = tid >> 6, lane = tid & 63, n = lane & 15, q4 = lane >> 4;
    const bf16* Z = (const bf16*)(a->ws + WS_ZH);
    LAS bf16* xs = (LAS bf16*)lds;
    LAS float* hid = (LAS float*)(lds + 40960);
    const int n0 = g * 16, t0 = n0 * 16, col = idx == 0 ? ZKC : ZVC;
    for (int i = tid; i < 272 * 8; i += NTHR) { const int tt = i >> 3, ch = i & 7, t = t0 + tt;
        v4u v = (v4u){0u, 0u, 0u, 0u}; if (t < SEQ) v = *(const v4u*)(Z + (size_t)(b * SEQ + t) * ZP + col + ch * 8);
        *(LAS v4u*)(xs + ((tt & 15) * 17 + (tt >> 4)) * 72 + ch * 8) = v; }
    __syncthreads();
    const float* pe = a->in[8] + (size_t)(l * 2 + idx) * 32 * 64;
    const bf16* w1t = (const bf16*)(a->ws + WS_W1T) + ((size_t)(l * 2 + idx) * 128 + wave * 16 + n) * 2048;
    const float* w2 = a->in[10] + (size_t)(l * 2 + idx) * 128 * 64;
    f32x4 acc = (f32x4){0.f, 0.f, 0.f, 0.f};
#pragma unroll 4
    for (int ks = 0; ks < 64; ++ks) {
        const int ll = ks >> 1, d0 = (ks & 1) * 32 + 8 * q4;
        const v4u xa = *(const LAS v4u*)(xs + ((ll & 15) * 17 + n + (ll >> 4)) * 72 + d0);
        const f32x4 p0 = *(const f32x4*)(pe + ll * 64 + d0), p1 = *(const f32x4*)(pe + ll * 64 + d0 + 4);
        v4u am; am.x = pg8::cvt_pk_bf16(bflo(xa.x) + p0[0], bfhi(xa.x) + p0[1]); am.y = pg8::cvt_pk_bf16(bflo(xa.y) + p0[2], bfhi(xa.y) + p0[3]);
        am.z = pg8::cvt_pk_bf16(bflo(xa.z) + p1[0], bfhi(xa.z) + p1[1]); am.w = pg8::cvt_pk_bf16(bflo(xa.w) + p1[2], bfhi(xa.w) + p1[3]);
        const bf16x8c bm = *(const bf16x8c*)(w1t + ks * 32 + 8 * q4);
        acc = __builtin_amdgcn_mfma_f32_16x16x32_bf16(__builtin_bit_cast(bf16x8c, am), bm, acc, 0, 0, 0);
    }
#pragma unroll
    for (int j = 0; j < 4; ++j) { const float sv = acc[j]; hid[(4 * q4 + j) * 128 + wave * 16 + n] = sv * sigmoidf_(sv); }
    __syncthreads();
    bf16* KC = (bf16*)(a->ws + (idx == 0 ? WS_KC : WS_VC)); bf16* VCT = (bf16*)(a->ws + WS_VC + 512 * 1024);
    for (int o = tid; o < 16 * 64; o += NTHR) { const int i = o >> 6, e2 = o & 63; float sv = 0.f;
#pragma unroll 16
        for (int ee = 0; ee < 128; ++ee) sv += hid[i * 128 + ee] * w2[ee * 64 + e2];
        const int nn = n0 + i; const bf16 val = nn < 255 ? (bf16)f2bf(sv) : (bf16)0;
        const int T = nn >> 5, kk = nn & 31;
        if (idx == 0) KC[(size_t)b * 256 * 64 + ((T * 8 + (e2 >> 3)) * 32 + kk) * 8 + (e2 & 7)] = val;
        else { const int k16 = kk & 15; VCT[(size_t)b * 256 * 64 + (((((T * 2 + (e2 >> 5)) * 2 + (kk >> 4)) * 2 + ((k16 >> 2) & 1)) * 32 + (e2 & 31)) * 8) + (k16 & 3) + 4 * (k16 >> 3)] = val; } }
    __syncthreads();
}
__device__ __forceinline__ void p4_dil_item(CArgsP a, int it, int lane) {
    const int blk64 = it & 63, bh = (it >> 6) & 31, g = it >> 11; const int b = bh >> 2, h = bh & 3;
    const int dd = g == 0 ? 1 : (g == 1 ? 4 : 16); const int per = 64 / dd;
    const int r = blk64 / per, i0 = (blk64 % per) * 64; const int hoff = 32 * (lane & 1);
    const bf16* Z = (const bf16*)(a->ws + WS_ZH); const size_t rowb = (size_t)b * SEQ;
    bf16* DO = (bf16*)(a->ws + WS_DO); float* DL = (float*)(a->ws + WS_DL);
    for (int sub = 0; sub < 2; ++sub) {
        const int i0s = i0 + sub * 32, qi = i0s + (lane >> 1), t = r + dd * qi;
        unsigned q[16]; load_q(q, Z + (rowb + t) * ZP + ZQ_DIL + h * 64 + hoff);
        NAcc acc; nacc_init(acc);
        banded(q, acc, Z + (rowb + r) * ZP + ZK_DIL + h * 64 + hoff, Z + (rowb + r) * ZP + ZV_DIL + h * 64 + hoff, (size_t)dd * ZP, i0s, qi, 128, alibi_slope(8 + h) * (float)dd);
        store_o_bf16(DO + ((size_t)g * M + rowb + t) * 256 + h * 64 + hoff, acc.o, 1.0f / acc.l);
        if ((lane & 1) == 0) DL[((size_t)g * M + rowb + t) * 4 + h] = acc.m + __logf(acc.l);
    }
}
__device__ __forceinline__ void p4_swa_item(CArgsP a, int l, int it, int lane) {
    const int blk = it & 63, bh = it >> 6; const int b = bh >> 2, h = bh & 3, kvh = h >> 1; const int hoff = 32 * (lane & 1);
    const bf16* Z = (const bf16*)(a->ws + WS_ZH); const size_t rowb = (size_t)b * SEQ;
    const float sink = a->in[11][l * 4 + h];
    for (int sub = 0; sub < 2; ++sub) {
        const int i0s = blk * 64 + sub * 32, t = i0s + (lane >> 1);
        unsigned q[16]; load_q(q, Z + (rowb + t) * ZP + ZQ_SWA + h * 64 + hoff);
        NAcc acc; nacc_init(acc);
        banded(q, acc, Z + rowb * ZP + ZK_SWA + kvh * 64 + hoff, Z + rowb * ZP + ZV_SWA + kvh * 64 + hoff, (size_t)ZP, i0s, t, 127, alibi_slope(h));
        const float lse = acc.m + __logf(acc.l); const float keep = sigmoidf_(lse - sink);
        store_o_bf16((bf16*)(a->ws + WS_O) + (rowb + t) * DM + (8 + h) * 64 + hoff, acc.o, keep / acc.l);
    }
}
__device__ __forceinline__ void p5_fox_item(CArgsP a, int it, int lane) {
    const int bh = it & 31, blk = 63 - (it >> 5); const int b = bh >> 2, h = bh & 3; const int hoff = 32 * (lane & 1);
    const bf16* Z = (const bf16*)(a->ws + WS_ZH); const size_t rowb = (size_t)b * SEQ; const float* c = (const float*)(a->ws + WS_CUM) + (size_t)bh * SEQ;
    const bf16* Kb = Z + rowb * ZP + ZK_FOX + h * 64 + hoff; const bf16* Vb = Z + rowb * ZP + ZV_FOX + h * 64 + hoff;
    for (int sub = 0; sub < 2; ++sub) {
        const int t = blk * 64 + sub * 32 + (lane >> 1);
        unsigned q[16]; load_q(q, Z + (rowb + t) * ZP + ZQ_FOX + h * 64 + hoff);
        NAcc acc; nacc_init(acc); const float ct = c[t];
        const int khi = blk * 64 + sub * 32 + 31;
#pragma unroll 1
        for (int k = 0; k <= khi; ++k) attend1(q, acc, Kb + (size_t)k * ZP, Vb + (size_t)k * ZP, k <= t, ct - c[k]);
        store_o_bf16((bf16*)(a->ws + WS_O) + (rowb + t) * DM + h * 64 + hoff, acc.o, 1.0f / acc.l);
    }
}
__device__ __forceinline__ void p5_cmp_item(CArgsP a, int it, LAS float* imps  , int lane) {
    const int blk = it & 63, b = it >> 6; const size_t rowb = (size_t)b * SEQ; const int hoff = 32 * (lane & 1);
    const bf16* Z = (const bf16*)(a->ws + WS_ZH); const float* ZS = (const float*)(a->ws + WS_ZS);
    const bf16* KC = (const bf16*)(a->ws + WS_KC) + (size_t)b * 256 * 64 + hoff; const bf16* VC = (const bf16*)(a->ws + WS_VC) + (size_t)b * 256 * 64 + hoff;
    float* OC = (float*)(a->ws + WS_OC);
    for (int j = 0; j < 64; ++j) imps[lane * 65 + j] = 0.f;
    for (int sub = 0; sub < 2; ++sub) {
        const int tt = sub * 32 + (lane >> 1), t = blk * 64 + tt;
        const int tmax = blk * 64 + sub * 32 + 31; const int ncm = tmax >= 31 ? (tmax - 31) / 16 + 1 : 0;
        for (int h = 0; h < 4; ++h) {
            const float slope = alibi_slope(4 + h);
            unsigned q[16]; load_q(q, Z + (rowb + t) * ZP + ZQ_NSA + h * 64 + hoff);
            NAcc acc; nacc_init(acc);
#pragma unroll 1
            for (int n = 0; n < ncm; ++n) { const int dist = t - (16 * n + 31); attend1(q, acc, KC + n * 64, VC + n * 64, dist >= 0, -slope * (float)dist); }
            const float g0 = sigmoidf_(ZS[(rowb + t) * 16 + 4 + h * 3 + 0]);
            const float inv = 1.0f / fmaxf(acc.l, 1e-30f);
            { f32x4* o4 = (f32x4*)(OC + (rowb + t) * 256 + h * 64 + hoff); const float sc = inv * g0;
#pragma unroll
              for (int i = 0; i < 8; ++i) o4[i] = (f32x4){acc.o[4 * i] * sc, acc.o[4 * i + 1] * sc, acc.o[4 * i + 2] * sc, acc.o[4 * i + 3] * sc}; }
            const float ms = (acc.m == -INFINITY) ? 0.f : acc.m;
            float cur = 0.f; const bool wr = (lane & 1) == 0;
#pragma unroll 1
            for (int n = 0; n < ncm; ++n) {
                const int dist = t - (16 * n + 31);
                const float dq = dot32(q, KC + n * 64);
                const float s = dist >= 0 ? dq * 0.125f - slope * (float)dist : -INFINITY;
                const float p = __expf(s - ms) * inv;
                cur += p;
                if ((n & 3) == 3) { if (wr) imps[tt * 65 + (n >> 2)] += cur; cur = p; }
            }
            if (ncm > 0 && (ncm >> 2) < 64 && wr) imps[tt * 65 + (ncm >> 2)] += cur;
        }
    }
    unsigned long long mymask = 0ull;
    for (int tt = 0; tt < 64; ++tt) {
        const int curb = blk;
        const float imp = imps[tt * 65 + lane];
        const bool causal = lane <= curb; const bool forced = (lane == 0) || (lane == curb) || (lane == curb - 1);
        const float score = causal ? (forced ? INFINITY : imp) : -INFINITY;
        int rank = 0;
        for (int jj = 0; jj < 64; ++jj) { const float o = __shfl(score, jj); rank += (o > score || (o == score && jj < lane)) ? 1 : 0; }
        const unsigned long long mk = __ballot(rank < 16 && causal);
        if (lane == tt) mymask = mk;
    }
    ((unsigned long long*)(a->ws + WS_MASK))[rowb + blk * 64 + lane] = mymask;
}
__device__ __forceinline__ void p5_dilcomb_item(CArgsP a, int it, int lane_in) {
    int lane = lane_in; asm volatile("" : "+v"(lane));
    const int blk = it & 63, bh = it >> 6; const int b = bh >> 2, h = bh & 3; const size_t row = (size_t)b * SEQ + blk * 64 + lane;
    const bf16* DO = (const bf16*)(a->ws + WS_DO); const float* DL = (const float*)(a->ws + WS_DL);
    const float l0 = DL[row * 4 + h], l1 = DL[((size_t)M + row) * 4 + h], l2 = DL[((size_t)2 * M + row) * 4 + h];
    const float mx = fmaxf(l0, fmaxf(l1, l2)); float w0 = __expf(l0 - mx), w1 = __expf(l1 - mx), w2 = __expf(l2 - mx); const float inv = 1.0f / (w0 + w1 + w2); w0 *= inv; w1 *= inv; w2 *= inv;
    const v4u* p0 = (const v4u*)(DO + row * 256 + h * 64); const v4u* p1 = (const v4u*)(DO + ((size_t)M + row) * 256 + h * 64); const v4u* p2 = (const v4u*)(DO + ((size_t)2 * M + row) * 256 + h * 64);
    v4u* o4 = (v4u*)((bf16*)(a->ws + WS_O) + row * DM + (12 + h) * 64);
#pragma unroll 2
    for (int i = 0; i < 8; ++i) { const v4u x = p0[i], y = p1[i], z = p2[i]; v4u w;
        w.x = pk2(w0 * bflo(x.x) + w1 * bflo(y.x) + w2 * bflo(z.x), w0 * bfhi(x.x) + w1 * bfhi(y.x) + w2 * bfhi(z.x));
        w.y = pk2(w0 * bflo(x.y) + w1 * bflo(y.y) + w2 * bflo(z.y), w0 * bfhi(x.y) + w1 * bfhi(y.y) + w2 * bfhi(z.y));
        w.z = pk2(w0 * bflo(x.z) + w1 * bflo(y.z) + w2 * bflo(z.z), w0 * bfhi(x.z) + w1 * bfhi(y.z) + w2 * bfhi(z.z));
        w.w = pk2(w0 * bflo(x.w) + w1 * bflo(y.w) + w2 * bflo(z.w), w0 * bfhi(x.w) + w1 * bfhi(y.w) + w2 * bfhi(z.w));
        o4[i] = w; }
}
__device__ __forceinline__ void p6_nsa_item(CArgsP a, int it, int lane) {
    const int bh = it & 31, blk = 63 - (it >> 5); const int b = bh >> 2, h = bh & 3; const size_t rowb = (size_t)b * SEQ; const int hoff = 32 * (lane & 1);
    const bf16* Z = (const bf16*)(a->ws + WS_ZH); const float* ZS = (const float*)(a->ws + WS_ZS);
    const float slope = alibi_slope(4 + h);
    for (int sub = 0; sub < 2; ++sub) {
        const int i0s = blk * 64 + sub * 32, t = i0s + (lane >> 1);
        unsigned q[16]; load_q(q, Z + (rowb + t) * ZP + ZQ_NSA + h * 64 + hoff);
        const unsigned long long mask = ((const unsigned long long*)(a->ws + WS_MASK))[rowb + t];
        float* OC = (float*)(a->ws + WS_OC) + (rowb + t) * 256 + h * 64 + hoff;
        const float g1 = sigmoidf_(ZS[(rowb + t) * 16 + 4 + h * 3 + 1]), g2 = sigmoidf_(ZS[(rowb + t) * 16 + 4 + h * 3 + 2]);
        {
            NAcc acc; nacc_init(acc);
            const bf16* Kb = Z + rowb * ZP + ZKS + hoff; const bf16* Vb = Z + rowb * ZP + ZVS + hoff;
            for (int j = 0; j <= blk; ++j) {
                const bool sel = (mask >> j) & 1ull;
                if (!__any(sel)) continue;
#pragma unroll 1
                for (int k = j * 64; k < j * 64 + 64; ++k) attend1(q, acc, Kb + (size_t)k * ZP, Vb + (size_t)k * ZP, sel && k <= t, -slope * (float)(t - k));
            }
            const float sc = g1 / fmaxf(acc.l, 1e-30f);
            f32x4* o4 = (f32x4*)OC;
#pragma unroll
            for (int i = 0; i < 8; ++i) { f32x4 v = o4[i]; v[0] += acc.o[4 * i] * sc; v[1] += acc.o[4 * i + 1] * sc; v[2] += acc.o[4 * i + 2] * sc; v[3] += acc.o[4 * i + 3] * sc; o4[i] = v; }
        }
        asm volatile("" ::: "memory");
        {
            NAcc acc; nacc_init(acc);
            banded(q, acc, Z + rowb * ZP + ZKW + hoff, Z + rowb * ZP + ZVW + hoff, (size_t)ZP, i0s, t, 511, slope);
            const float sc = g2 / acc.l;
            const f32x4* o4 = (const f32x4*)OC; v4u* d4 = (v4u*)((bf16*)(a->ws + WS_O) + (rowb + t) * DM + (4 + h) * 64 + hoff);
#pragma unroll
            for (int i = 0; i < 4; ++i) { const f32x4 x = o4[2 * i], y = o4[2 * i + 1]; v4u w;
                w.x = pk2(x[0] + acc.o[8 * i] * sc, x[1] + acc.o[8 * i + 1] * sc); w.y = pk2(x[2] + acc.o[8 * i + 2] * sc, x[3] + acc.o[8 * i + 3] * sc);
                w.z = pk2(y[0] + acc.o[8 * i + 4] * sc, y[1] + acc.o[8 * i + 5] * sc); w.w = pk2(y[2] + acc.o[8 * i + 6] * sc, y[3] + acc.o[8 * i + 7] * sc); d4[i] = w; }
        }
    }
}

typedef short bf16x8 __attribute__((ext_vector_type(8)));
typedef float f32x16 __attribute__((ext_vector_type(16)));
typedef unsigned u32x2_t __attribute__((ext_vector_type(2)));
constexpr float LOG2E = 1.4426950408889634f, C2S = 0.125f * 1.4426950408889634f, LN2F = 0.6931471805599453f;
constexpr size_t WS_VT_SWA = 504 * MiB;
constexpr size_t WS_KF_FOX = WS_OC, WS_VF_FOX = WS_OC + 16 * MiB;
constexpr size_t WS_KF_NS = 480 * MiB, WS_VF_NS = 484 * MiB, WS_KF_NW = 488 * MiB, WS_VF_NW = 492 * MiB;
constexpr size_t WS_OCB = WS_XG + 48 * MiB;
constexpr size_t WS_VT_DIL = WS_XG;
constexpr size_t WS_VCT = WS_VC + 512 * 1024;
constexpr size_t WS_CKA = WS_W + OFF_WD2 + SZ_WD;
static_assert(OFF_WD2 + SZ_WD + 2 * MiB <= LAYER_W, "CKA fits behind layer 0's weights");
static_assert(WS_END <= 480 * MiB, "small region vs V^T buffers");

__device__ __forceinline__ int crow(int r, int hi) { return (r & 3) + 8 * (r >> 2) + 4 * hi; }
struct FA { f32x16 o0, o1; float m, l; };
__device__ __forceinline__ void fa_init(FA& s) { s.m = -INFINITY; s.l = 0.f;
#pragma unroll
    for (int r = 0; r < 16; ++r) { s.o0[r] = 0.f; s.o1[r] = 0.f; } }
__device__ __forceinline__ void load_frag4(bf16x8 (&f)[4], const bf16* row, int hi) {
#pragma unroll
    for (int d0 = 0; d0 < 4; ++d0) f[d0] = *(const bf16x8*)(row + d0 * 16 + hi * 8);
}
__device__ __forceinline__ void load_vfrag(bf16x8 (&vf)[2][2], const bf16* vt, size_t vstride) {
#pragma unroll
    for (int dh = 0; dh < 2; ++dh)
#pragma unroll
        for (int i = 0; i < 2; ++i) { const bf16* p = vt + (size_t)dh * 32 * vstride + 16 * i;
            const u32x2_t a = *(const u32x2_t*)p, b = *(const u32x2_t*)(p + 8); vf[dh][i] = __builtin_bit_cast(bf16x8, (v4u){a.x, a.y, b.x, b.y}); }
}
__device__ __forceinline__ f32x16 qk_tile(const bf16x8 (&kf)[4], const bf16x8 (&qf)[4]) {
    f32x16 s;
#pragma unroll
    for (int r = 0; r < 16; ++r) s[r] = 0.f;
#pragma unroll
    for (int d0 = 0; d0 < 4; ++d0) s = __builtin_amdgcn_mfma_f32_32x32x16_bf16(kf[d0], qf[d0], s, 0, 0, 0);
    return s;
}
__device__ __forceinline__ void fa_softmax_pv(FA& st, f32x16& s, const bf16x8 (&vf)[2][2]) {
    float tmax = s[0];
#pragma unroll
    for (int r = 1; r < 16; ++r) tmax = fmaxf(tmax, s[r]);
    tmax = fmaxf(tmax, __shfl_xor(tmax, 32));
    const float mn = fmaxf(st.m, tmax);
    if (__any(mn > st.m)) {
        const float ms0 = (mn == -INFINITY) ? 0.f : mn;
        const float alpha = __builtin_amdgcn_exp2f(st.m - ms0);
        st.l *= alpha;
#pragma unroll
        for (int r = 0; r < 16; ++r) { st.o0[r] *= alpha; st.o1[r] *= alpha; }
        st.m = mn;
    }
    const float ms = (st.m == -INFINITY) ? 0.f : st.m;
    float ps = 0.f;
#pragma unroll
    for (int r = 0; r < 16; ++r) { s[r] = __builtin_amdgcn_exp2f(s[r] - ms); ps += s[r]; }
    st.l += ps;
    unsigned pk[8];
#pragma unroll
    for (int j = 0; j < 8; ++j) pk[j] = pg8::cvt_pk_bf16(s[2 * j], s[2 * j + 1]);
#pragma unroll
    for (int i = 0; i < 2; ++i) { const bf16x8 pb = __builtin_bit_cast(bf16x8, (v4u){pk[4 * i], pk[4 * i + 1], pk[4 * i + 2], pk[4 * i + 3]});
        st.o0 = __builtin_amdgcn_mfma_f32_32x32x16_bf16(vf[0][i], pb, st.o0, 0, 0, 0);
        st.o1 = __builtin_amdgcn_mfma_f32_32x32x16_bf16(vf[1][i], pb, st.o1, 0, 0, 0); }
}
__device__ __forceinline__ void fa_softmax_pv_lin(FA& st, f32x16& s, const bf16x8 (&vf)[2][2], float sc, float bias) {
    float tmax = s[0];
#pragma unroll
    for (int r = 1; r < 16; ++r) tmax = fmaxf(tmax, s[r]);
    tmax = fmaxf(tmax, __shfl_xor(tmax, 32));
    const float mn = fmaxf(st.m, tmax * sc + bias);
    if (__any(mn > st.m)) {
        const float alpha = __builtin_amdgcn_exp2f(st.m - mn);
        st.l *= alpha;
#pragma unroll
        for (int r = 0; r < 16; ++r) { st.o0[r] *= alpha; st.o1[r] *= alpha; }
        st.m = mn;
    }
    const float bb = bias - st.m;
    float ps = 0.f;
#pragma unroll
    for (int r = 0; r < 16; ++r) { s[r] = __builtin_amdgcn_exp2f(s[r] * sc + bb); ps += s[r]; }
    st.l += ps;
    unsigned pk[8];
#pragma unroll
    for (int j = 0; j < 8; ++j) pk[j] = pg8::cvt_pk_bf16(s[2 * j], s[2 * j + 1]);
#pragma unroll
    for (int i = 0; i < 2; ++i) { const bf16x8 pb = __builtin_bit_cast(bf16x8, (v4u){pk[4 * i], pk[4 * i + 1], pk[4 * i + 2], pk[4 * i + 3]});
        st.o0 = __builtin_amdgcn_mfma_f32_32x32x16_bf16(vf[0][i], pb, st.o0, 0, 0, 0);
        st.o1 = __builtin_amdgcn_mfma_f32_32x32x16_bf16(vf[1][i], pb, st.o1, 0, 0, 0); }
}
struct FTile { bf16x8 k[4]; bf16x8 ka; };
struct VTile { bf16x8 v[2][2]; };
struct RangeIt { int tlo, thi, tfull;
    __device__ __forceinline__ int first() const { return tlo <= thi ? tlo : -1; }
    __device__ __forceinline__ int next(int t) const { return t < thi ? t + 1 : -1; }
    __device__ __forceinline__ bool masked(int t) const { return t < tfull || t == thi; }
    __device__ __forceinline__ bool block_ok(int t) const { return t >= tfull && t + 5 < thi; }
    __device__ __forceinline__ int clampt(int t) const { return t < thi ? t : thi; } };
template <bool CK, bool FRAG, bool VFRAG, class F, class It> __device__ __forceinline__ void fa_stream(FA& st, const bf16x8 (&qf)[4], const bf16* Kb, size_t kstride, const bf16* vtl, size_t vstride, const bf16* cka, const It& it, int r32, int hi, F f) {
    int ta = it.first(); if (ta < 0) return;
    int tb = it.next(ta), tc = tb >= 0 ? it.next(tb) : -1;
    FTile T0, T1, T2; VTile V0, V1;
    bf16x8 qa;
#pragma unroll
    for (int j = 0; j < 8; ++j) qa[j] = (short)((hi == 0 && j < 3) ? 0x3F80 : 0);
#define FA_LOAD(T, t_) do { if (FRAG) { _Pragma("unroll") for (int d0_ = 0; d0_ < 4; ++d0_) T.k[d0_] = *(const bf16x8*)(Kb + (size_t)(t_) * 2048 + ((d0_ * 2 + hi) * 32 + r32) * 8); } \
        else load_frag4(T.k, Kb + (size_t)((t_) * 32 + r32) * kstride, hi); \
        if (CK) { T.ka = *(const bf16x8*)(cka + (size_t)((t_) * 32 + r32) * 8); } } while (0)
#define FA_LOADV(V, t_) do { if (VFRAG) { _Pragma("unroll") for (int u_ = 0; u_ < 4; ++u_) V.v[u_ >> 1][u_ & 1] = *(const bf16x8*)(vtl + (size_t)(t_) * 2048 + ((u_ * 2 + hi) * 32 + r32) * 8); } \
        else load_vfrag(V.v, vtl + (t_) * 32, vstride); } while (0)
#define FA_STEP(T, V, t_) do { f32x16 s_ = qk_tile(T.k, qf); const int k0_ = (t_) * 32; \
        if (CK) { bf16x8 ka_ = T.ka; if (hi) { _Pragma("unroll") for (int j = 0; j < 8; ++j) ka_[j] = 0; } s_ = __builtin_amdgcn_mfma_f32_32x32x16_bf16(ka_, qa, s_, 0, 0, 0); } \
        f.begin_tile(k0_); if (f.tile_masked(it.masked(t_))) { _Pragma("unroll") for (int r = 0; r < 16; ++r) { const int key_ = k0_ + crow(r, hi); s_[r] = f.valid(key_) ? f.plain(key_, s_[r]) : -INFINITY; } } \
        else { _Pragma("unroll") for (int r = 0; r < 16; ++r) s_[r] = f.plain(k0_ + crow(r, hi), s_[r]); } \
        fa_softmax_pv(st, s_, V.v); } while (0)
    const int tsafe = ta;
#define CL(t_) ((t_) >= 0 ? (t_) : tsafe)
    FA_LOADV(V0, ta); FA_LOAD(T0, ta); FA_LOAD(T1, CL(tb));
#define FA_STEP_U(T, V, t_) do { f32x16 s_ = qk_tile(T.k, qf); const int k0_ = (t_) * 32; \
        if (CK) { bf16x8 ka_ = T.ka; if (hi) { _Pragma("unroll") for (int j = 0; j < 8; ++j) ka_[j] = 0; } s_ = __builtin_amdgcn_mfma_f32_32x32x16_bf16(ka_, qa, s_, 0, 0, 0); } \
        f.begin_tile(k0_); if (F::LINEAR) fa_softmax_pv_lin(st, s_, V.v, C2S, f.lin_bias()); \
        else { _Pragma("unroll") for (int r = 0; r < 16; ++r) s_[r] = f.plain(k0_ + crow(r, hi), s_[r]); fa_softmax_pv(st, s_, V.v); } } while (0)
#pragma unroll 1
    while (it.block_ok(ta)) {
        FA_LOADV(V1, ta + 1); FA_LOAD(T2, ta + 2); FA_STEP_U(T0, V0, ta);
        FA_LOADV(V0, ta + 2); FA_LOAD(T0, ta + 3); FA_STEP_U(T1, V1, ta + 1);
        FA_LOADV(V1, ta + 3); FA_LOAD(T1, ta + 4); FA_STEP_U(T2, V0, ta + 2);
        FA_LOADV(V0, ta + 4); FA_LOAD(T2, ta + 5); FA_STEP_U(T0, V1, ta + 3);
        FA_LOADV(V1, ta + 5); FA_LOAD(T0, it.clampt(ta + 6)); FA_STEP_U(T1, V0, ta + 4);
        FA_LOADV(V0, it.clampt(ta + 6)); FA_LOAD(T1, it.clampt(ta + 7)); FA_STEP_U(T2, V1, ta + 5);
        ta += 6;
    }
    tb = it.next(ta); tc = tb >= 0 ? it.next(tb) : -1;
#undef FA_STEP_U
#pragma unroll 1
    for (;;) {
        FA_LOADV(V1, CL(tb)); FA_LOAD(T2, CL(tc));
        FA_STEP(T0, V0, ta); if (tb < 0) break; ta = tc >= 0 ? it.next(tc) : -1;
        FA_LOADV(V0, CL(tc)); FA_LOAD(T0, CL(ta));
        FA_STEP(T1, V1, tb); if (tc < 0) break; tb = ta >= 0 ? it.next(ta) : -1;
        FA_LOADV(V1, CL(ta)); FA_LOAD(T1, CL(tb));
        FA_STEP(T2, V0, tc); if (ta < 0) break; tc = tb >= 0 ? it.next(tb) : -1;
        FA_LOADV(V0, CL(tb)); FA_LOAD(T2, CL(tc));
        FA_STEP(T0, V1, ta); if (tb < 0) break; ta = tc >= 0 ? it.next(tc) : -1;
        FA_LOADV(V1, CL(tc)); FA_LOAD(T0, CL(ta));
        FA_STEP(T1, V0, tb); if (tc < 0) break; tb = ta >= 0 ? it.next(ta) : -1;
        FA_LOADV(V0, CL(ta)); FA_LOAD(T1, CL(tb));
        FA_STEP(T2, V1, tc); if (ta < 0) break; tc = tb >= 0 ? it.next(tb) : -1;
    }
#undef CL
#undef FA_LOADV
#undef FA_LOAD
#undef FA_STEP
}
__device__ __forceinline__ void store_ot_bf16(bf16* orow, const f32x16& o0, const f32x16& o1, float sc, int hi) {
#pragma unroll
    for (int a4 = 0; a4 < 4; ++a4) {
        u32x2_t w0, w1;
        w0.x = pg8::cvt_pk_bf16(o0[4 * a4] * sc, o0[4 * a4 + 1] * sc); w0.y = pg8::cvt_pk_bf16(o0[4 * a4 + 2] * sc, o0[4 * a4 + 3] * sc);
        w1.x = pg8::cvt_pk_bf16(o1[4 * a4] * sc, o1[4 * a4 + 1] * sc); w1.y = pg8::cvt_pk_bf16(o1[4 * a4 + 2] * sc, o1[4 * a4 + 3] * sc);
        *(u32x2_t*)(orow + 8 * a4 + 4 * hi) = w0; *(u32x2_t*)(orow + 32 + 8 * a4 + 4 * hi) = w1;
    }
}
struct BandF { int qi, maxd; float slope2;
    static constexpr bool LINEAR = false;
    __device__ __forceinline__ float lin_bias() const { return 0.f; }
    __device__ __forceinline__ void begin_tile(int) {}
    __device__ __forceinline__ bool tile_masked(bool m) const { return m; }
    __device__ __forceinline__ float plain(int key, float raw) const { return raw * C2S - slope2 * (float)(qi - key); }
    __device__ __forceinline__ bool valid(int key) const { const int dist = qi - key; return dist >= 0 && dist <= maxd; } };
__device__ __forceinline__ int band_tfull(int i0, int maxd) { const int x = i0 + 31 - maxd; return x <= 0 ? 0 : (x + 31) >> 5; }

__device__ __forceinline__ void p4_vt_item(CArgsP a, int it, LAS unsigned short* scr  , int lane_in) {
    int lane = lane_in; asm volatile("" : "+v"(lane));
    const int ct = 6 + it % 6, tt = it / 6; const int b = tt >> 6, t0 = (tt & 63) * 64;
    const int scol = ct < 4 ? ZV_FOX + ct * 64 : (ct == 4 ? ZVS : (ct == 5 ? ZVW : (ct < 8 ? ZV_SWA + (ct - 6) * 64 : ZV_DIL + (ct - 8) * 64)));
    const bf16* Z = (const bf16*)(a->ws + WS_ZH);
    { const v4u* src = (const v4u*)(Z + ((size_t)b * SEQ + t0 + lane) * ZP + scol);
#pragma unroll
      for (int i = 0; i < 8; ++i) { const v4u w = src[i]; LAS unsigned* d = (LAS unsigned*)(scr + lane * 66 + 8 * i); d[0] = w.x; d[1] = w.y; d[2] = w.z; d[3] = w.w; } }
    asm volatile("s_waitcnt lgkmcnt(0)" ::: "memory");
    unsigned v[64];
#pragma unroll
    for (int t = 0; t < 64; ++t) v[t] = scr[t * 66 + lane];
    asm volatile("s_waitcnt lgkmcnt(0)" ::: "memory");
    if (ct < 8) {
        bf16* dst = (bf16*)(a->ws + WS_VT_SWA);
        const int ncol = 128; const int c = (ct - 6) * 64 + lane;
        v4u* o = (v4u*)(dst + ((size_t)b * ncol + c) * SEQ + t0);
#pragma unroll
        for (int i = 0; i < 8; ++i) o[i] = (v4u){v[8 * i] | (v[8 * i + 1] << 16), v[8 * i + 2] | (v[8 * i + 3] << 16), v[8 * i + 4] | (v[8 * i + 5] << 16), v[8 * i + 6] | (v[8 * i + 7] << 16)};
    } else {
        const int c = (ct - 8) * 64 + lane; bf16* base = (bf16*)(a->ws + WS_VT_DIL) + ((size_t)b * 256 + c) * SEQ;
        { v4u* o = (v4u*)(base + t0);
#pragma unroll
          for (int i = 0; i < 8; ++i) o[i] = (v4u){v[8 * i] | (v[8 * i + 1] << 16), v[8 * i + 2] | (v[8 * i + 3] << 16), v[8 * i + 4] | (v[8 * i + 5] << 16), v[8 * i + 6] | (v[8 * i + 7] << 16)}; }
        { bf16* b1 = base + (size_t)BATCH * 256 * SEQ;
#pragma unroll
          for (int r = 0; r < 4; ++r) { v4u* o = (v4u*)(b1 + r * (SEQ / 4) + t0 / 4);
#pragma unroll
              for (int i = 0; i < 2; ++i) o[i] = (v4u){v[4 * (8 * i) + r] | (v[4 * (8 * i + 1) + r] << 16), v[4 * (8 * i + 2) + r] | (v[4 * (8 * i + 3) + r] << 16),
                                                       v[4 * (8 * i + 4) + r] | (v[4 * (8 * i + 5) + r] << 16), v[4 * (8 * i + 6) + r] | (v[4 * (8 * i + 7) + r] << 16)}; } }
        { bf16* b2 = base + (size_t)2 * BATCH * 256 * SEQ;
#pragma unroll
          for (int r = 0; r < 16; ++r) { u32x2_t w; w.x = v[r] | (v[16 + r] << 16); w.y = v[32 + r] | (v[48 + r] << 16); *(u32x2_t*)(b2 + r * (SEQ / 16) + t0 / 16) = w; } }
    }
}

__device__ __forceinline__ void p4_kfrag_item(CArgsP a, int it, int lane_in) {
    int lane = lane_in; asm volatile("" : "+v"(lane));
    const int slot = it % 6, tt = it / 6; const int b = tt >> 7, T = tt & 127, r32 = lane & 31, hi = lane >> 5;
    const int col = slot < 4 ? ZK_FOX + slot * 64 : (slot == 4 ? ZKS : ZKW);
    const bf16* src = (const bf16*)(a->ws + WS_ZH) + ((size_t)b * SEQ + T * 32 + r32) * ZP + col + hi * 8;
    bf16* dst = (bf16*)(a->ws + (slot < 4 ? WS_KF_FOX : (slot == 4 ? WS_KF_NS : WS_KF_NW))) + ((size_t)(slot < 4 ? b * 4 + slot : b) * 128 + T) * 2048 + (hi * 32 + r32) * 8;
#pragma unroll
    for (int d0 = 0; d0 < 4; ++d0) *(v4u*)(dst + d0 * 512) = *(const v4u*)(src + d0 * 16);
}
__device__ __forceinline__ void p4_vfrag_item(CArgsP a, int it, LAS unsigned short* scr  , int lane_in) {
    int lane = lane_in; asm volatile("" : "+v"(lane));
    const int slot = it % 6, tt = it / 6; const int b = tt >> 7, T = tt & 127, r32 = lane & 31, hi = lane >> 5;
    const int col = slot < 4 ? ZV_FOX + slot * 64 : (slot == 4 ? ZVS : ZVW);
    { const v4u* src = (const v4u*)((const bf16*)(a->ws + WS_ZH) + ((size_t)b * SEQ + T * 32 + r32) * ZP + col + hi * 32);
#pragma unroll
      for (int i = 0; i < 4; ++i) { const v4u w = src[i]; LAS unsigned* d = (LAS unsigned*)(scr + r32 * 66 + hi * 32 + 8 * i); d[0] = w.x; d[1] = w.y; d[2] = w.z; d[3] = w.w; } }
    asm volatile("s_waitcnt lgkmcnt(0)" ::: "memory");
    bf16* dst = (bf16*)(a->ws + (slot < 4 ? WS_VF_FOX : (slot == 4 ? WS_VF_NS : WS_VF_NW))) + ((size_t)(slot < 4 ? b * 4 + slot : b) * 128 + T) * 2048 + (hi * 32 + r32) * 8;
#pragma unroll
    for (int dh = 0; dh < 2; ++dh)
#pragma unroll
        for (int i = 0; i < 2; ++i) { unsigned v[8];
#pragma unroll
            for (int j = 0; j < 8; ++j) v[j] = scr[(16 * i + 4 * hi + (j & 3) + 8 * (j >> 2)) * 66 + dh * 32 + r32];
            *(v4u*)(dst + (dh * 2 + i) * 512) = (v4u){v[0] | (v[1] << 16), v[2] | (v[3] << 16), v[4] | (v[5] << 16), v[6] | (v[7] << 16)}; }
    asm volatile("s_waitcnt lgkmcnt(0)" ::: "memory");
}

__device__ __forceinline__ void p4_vfrag2_item(CArgsP a, int it, LAS unsigned short* scr  , int lane_in) {
    int lane = lane_in; asm volatile("" : "+v"(lane));
    const int T = it & 127, b = (it >> 7) & 7, slot = it >> 10, r32 = lane & 31, hi = lane >> 5;
    int col, dd, sl; bf16* dst;
    if (slot < 2) { col = ZV_SWA + slot * 64; dd = 1; sl = SEQ; dst = (bf16*)(a->ws + WS_VT_SWA) + ((size_t)(b * 2 + slot) * 128 + T) * 2048; }
    else { const int g = (slot - 2) >> 2, h = (slot - 2) & 3; col = ZV_DIL + h * 64; dd = g == 0 ? 1 : (g == 1 ? 4 : 16); sl = SEQ / dd; dst = (bf16*)(a->ws + WS_VT_DIL) + ((size_t)(g * 32 + b * 4 + h) * 128 + T) * 2048; }
    const int p = T * 32 + r32, r = p / sl, j = p % sl, tok = r + dd * j;
    { const v4u* src = (const v4u*)((const bf16*)(a->ws + WS_ZH) + ((size_t)b * SEQ + tok) * ZP + col + hi * 32);
#pragma unroll
      for (int i = 0; i < 4; ++i) { const v4u w = src[i]; LAS unsigned* d = (LAS unsigned*)(scr + r32 * 66 + hi * 32 + 8 * i); d[0] = w.x; d[1] = w.y; d[2] = w.z; d[3] = w.w; } }
    asm volatile("s_waitcnt lgkmcnt(0)" ::: "memory");
    dst += (hi * 32 + r32) * 8;
#pragma unroll
    for (int dh = 0; dh < 2; ++dh)
#pragma unroll
        for (int i = 0; i < 2; ++i) { unsigned v[8];
#pragma unroll
            for (int jj = 0; jj < 8; ++jj) v[jj] = scr[(16 * i + 4 * hi + (jj & 3) + 8 * (jj >> 2)) * 66 + dh * 32 + r32];
            *(v4u*)(dst + (dh * 2 + i) * 512) = (v4u){v[0] | (v[1] << 16), v[2] | (v[3] << 16), v[4] | (v[5] << 16), v[6] | (v[7] << 16)}; }
    asm volatile("s_waitcnt lgkmcnt(0)" ::: "memory");
}

struct FoxF { int tq; float cq2;
    static constexpr bool LINEAR = true;
    __device__ __forceinline__ float lin_bias() const { return cq2; }
    __device__ __forceinline__ void begin_tile(int) {}
    __device__ __forceinline__ bool tile_masked(bool m) const { return m; }
    __device__ __forceinline__ float plain(int, float raw) const { return raw * C2S + cq2; }
    __device__ __forceinline__ bool valid(int key) const { return key <= tq; } };
__device__ __forceinline__ void fa_fox_item(CArgsP a, int bh, int qt, int lane_in) {
    int lane = lane_in; asm volatile("" : "+v"(lane));
    const int b = bh >> 2, h = bh & 3, r32 = lane & 31, hi = lane >> 5; const int tq = qt * 32 + r32; const size_t rowb = (size_t)b * SEQ;
    const bf16* Z = (const bf16*)(a->ws + WS_ZH); const float* c = (const float*)(a->ws + WS_CUM) + (size_t)bh * SEQ;
    bf16x8 qf[4]; load_frag4(qf, Z + (rowb + tq) * ZP + ZQ_FOX + h * 64, hi);
    FA st; fa_init(st);
    const bf16* vtl = (const bf16*)(a->ws + WS_VF_FOX) + (size_t)bh * 128 * 2048;
    fa_stream<true, true, true>(st, qf, (const bf16*)(a->ws + WS_KF_FOX) + (size_t)bh * 128 * 2048, (size_t)ZP, vtl, (size_t)SEQ, (const bf16*)(a->ws + WS_CKA) + (size_t)bh * SEQ * 8, RangeIt{0, qt, 0}, r32, hi, FoxF{tq, c[tq] * LOG2E});
    const float l = st.l + __shfl_xor(st.l, 32);
    store_ot_bf16((bf16*)(a->ws + WS_O) + (rowb + tq) * DM + h * 64, st.o0, st.o1, 1.0f / l, hi);
}
__device__ __forceinline__ void fa_swa_item(CArgsP a, int l_, int it, int lane_in) {
    int lane = lane_in; asm volatile("" : "+v"(lane));
    const int qt = it & 127, bh = it >> 7; const int b = bh >> 2, h = bh & 3, kvh = h >> 1, r32 = lane & 31, hi = lane >> 5; const int tq = qt * 32 + r32; const size_t rowb = (size_t)b * SEQ;
    const bf16* Z = (const bf16*)(a->ws + WS_ZH);
    bf16x8 qf[4]; load_frag4(qf, Z + (rowb + tq) * ZP + ZQ_SWA + h * 64, hi);
    FA st; fa_init(st);
    const bf16* vtl = (const bf16*)(a->ws + WS_VT_SWA) + (size_t)(b * 2 + kvh) * 128 * 2048;
    int tlo = (qt * 32 - 127); tlo = tlo < 0 ? 0 : tlo >> 5;
    fa_stream<false, false, true>(st, qf, Z + rowb * ZP + ZK_SWA + kvh * 64, (size_t)ZP, vtl, (size_t)SEQ, nullptr, RangeIt{tlo, qt, band_tfull(qt * 32, 127)}, r32, hi, BandF{tq, 127, alibi_slope(h) * LOG2E});
    const float l = st.l + __shfl_xor(st.l, 32);
    const float lse = (st.m + __log2f(l)) * LN2F; const float keep = sigmoidf_(lse - a->in[11][l_ * 4 + h]);
    store_ot_bf16((bf16*)(a->ws + WS_O) + (rowb + tq) * DM + (8 + h) * 64, st.o0, st.o1, keep / l, hi);
}
__device__ __forceinline__ void fa_dil_item(CArgsP a, int it, int lane_in) {
    int lane = lane_in; asm volatile("" : "+v"(lane));
    const int pt = it & 127, bh = (it >> 7) & 31, g = it >> 12; const int b = bh >> 2, h = bh & 3, r32 = lane & 31, hi = lane >> 5; const size_t rowb = (size_t)b * SEQ;
    const int dd = g == 0 ? 1 : (g == 1 ? 4 : 16); const int sl = SEQ / dd;
    const int p0 = pt * 32; const int r = p0 / sl, j0 = p0 % sl; const int qt = j0 >> 5; const int qi = j0 + r32; const int t = r + dd * qi;
    const bf16* Z = (const bf16*)(a->ws + WS_ZH);
    bf16x8 qf[4]; load_frag4(qf, Z + (rowb + t) * ZP + ZQ_DIL + h * 64, hi);
    FA st; fa_init(st);
    const bf16* vtl = (const bf16*)(a->ws + WS_VT_DIL) + ((size_t)(g * 32 + bh) * 128 + (r * sl) / 32) * 2048;
    int tlo = j0 - 128; tlo = tlo < 0 ? 0 : tlo >> 5;
    fa_stream<false, false, true>(st, qf, Z + (rowb + r) * ZP + ZK_DIL + h * 64, (size_t)dd * ZP, vtl, (size_t)SEQ, nullptr, RangeIt{tlo, qt, band_tfull(j0, 128)}, r32, hi, BandF{qi, 128, alibi_slope(8 + h) * (float)dd * LOG2E});
    const float l = st.l + __shfl_xor(st.l, 32);
    store_ot_bf16((bf16*)(a->ws + WS_DO) + ((size_t)g * M + rowb + t) * 256 + h * 64, st.o0, st.o1, 1.0f / l, hi);
    if (hi == 0) ((float*)(a->ws + WS_DL))[((size_t)g * M + rowb + t) * 4 + h] = (st.m + __log2f(l)) * LN2F;
}
__device__ __forceinline__ void fa_cmp_passes(CArgsP a, int b, int qt, int h0, int h1, LAS float* imps  , int lane_in) {
    int lane = lane_in; asm volatile("" : "+v"(lane));
    for (int j = lane; j < 32 * 65; j += 64) imps[j] = 0.f;
    const int r32 = lane & 31, hi = lane >> 5; const int tq = qt * 32 + r32; const size_t rowb = (size_t)b * SEQ;
    const bf16* Z = (const bf16*)(a->ws + WS_ZH); const float* ZS = (const float*)(a->ws + WS_ZS);
    const bf16* KC = (const bf16*)(a->ws + WS_KC) + (size_t)b * 256 * 64; const bf16* VCF = (const bf16*)(a->ws + WS_VCT) + (size_t)b * 256 * 64;
    const int tmax = qt * 32 + 31; const int ncm = tmax >= 31 ? (tmax - 31) / 16 + 1 : 0; const int nt = (ncm + 31) >> 5;
    for (int h = h0; h < h1; ++h) {
        const float slope2 = alibi_slope(4 + h) * LOG2E;
        bf16x8 qf[4]; load_frag4(qf, Z + (rowb + tq) * ZP + ZQ_NSA + h * 64, hi);
        float m = -INFINITY, l = 0.f;
        bf16x8 kA[4], kB[4]; bf16x8 vA[2][2], vB[2][2];
#define CMP_LOADK(K_, t_) do { _Pragma("unroll") for (int d0_ = 0; d0_ < 4; ++d0_) K_[d0_] = *(const bf16x8*)(KC + (size_t)(t_) * 2048 + ((d0_ * 2 + hi) * 32 + r32) * 8); } while (0)
#define CMP_LOADV(V_, t_) do { _Pragma("unroll") for (int u_ = 0; u_ < 4; ++u_) V_[u_ >> 1][u_ & 1] = *(const bf16x8*)(VCF + (size_t)(t_) * 2048 + ((u_ * 2 + hi) * 32 + r32) * 8); } while (0)
#define CMP_P1(K_, t_) do { f32x16 s = qk_tile(K_, qf); float tm = -INFINITY; \
            _Pragma("unroll") for (int r = 0; r < 16; ++r) { const int n = (t_) * 32 + crow(r, hi); const int dist = tq - (16 * n + 31); s[r] = (dist >= 0 && n < 255) ? s[r] * C2S - slope2 * (float)dist : -INFINITY; tm = fmaxf(tm, s[r]); } \
            tm = fmaxf(tm, __shfl_xor(tm, 32)); \
            const float mn = fmaxf(m, tm), ms_ = (mn == -INFINITY) ? 0.f : mn; float ps = 0.f; \
            _Pragma("unroll") for (int r = 0; r < 16; ++r) ps += __builtin_amdgcn_exp2f(s[r] - ms_); \
            l = l * __builtin_amdgcn_exp2f(m - ms_) + ps; m = mn; } while (0)
        if (nt > 0) {
            CMP_LOADK(kA, 0);
#pragma unroll 1
            for (int t = 0;; t += 2) {
                CMP_LOADK(kB, t + 1 < nt ? t + 1 : nt - 1); CMP_P1(kA, t); if (t + 1 >= nt) break;
                CMP_LOADK(kA, t + 2 < nt ? t + 2 : nt - 1); CMP_P1(kB, t + 1); if (t + 2 >= nt) break;
            }
        }
        l += __shfl_xor(l, 32);
        const float inv = 1.0f / fmaxf(l, 1e-30f), ms = (m == -INFINITY) ? 0.f : m;
        f32x16 o0, o1;
#pragma unroll
        for (int r = 0; r < 16; ++r) { o0[r] = 0.f; o1[r] = 0.f; }
#define CMP_P2(K_, V_, t_) do { f32x16 s = qk_tile(K_, qf); \
            _Pragma("unroll") for (int r = 0; r < 16; ++r) { const int n = (t_) * 32 + crow(r, hi); const int dist = tq - (16 * n + 31); \
                s[r] = (dist >= 0 && n < 255) ? __builtin_amdgcn_exp2f(s[r] * C2S - slope2 * (float)dist - ms) * inv : 0.f; } \
            { float pt_[4]; _Pragma("unroll") for (int a4 = 0; a4 < 4; ++a4) pt_[a4] = __shfl_xor(s[4 * a4 + 3], 32);        \
              _Pragma("unroll") for (int a4 = 0; a4 < 4; ++a4) { const float bs = (s[4 * a4] + s[4 * a4 + 1]) + (s[4 * a4 + 2] + s[4 * a4 + 3]); \
                  const float ad = hi ? pt_[a4] : (a4 ? pt_[a4 ? a4 - 1 : 0] : carry); imps[r32 * 65 + 8 * (t_) + 2 * a4 + hi] = bs + ad; } \
              carry = pt_[3]; } \
            unsigned pk[8]; \
            _Pragma("unroll") for (int j = 0; j < 8; ++j) pk[j] = pg8::cvt_pk_bf16(s[2 * j], s[2 * j + 1]); \
            _Pragma("unroll") for (int i = 0; i < 2; ++i) { const bf16x8 pb = __builtin_bit_cast(bf16x8, (v4u){pk[4 * i], pk[4 * i + 1], pk[4 * i + 2], pk[4 * i + 3]}); \
                o0 = __builtin_amdgcn_mfma_f32_32x32x16_bf16(V_[0][i], pb, o0, 0, 0, 0); o1 = __builtin_amdgcn_mfma_f32_32x32x16_bf16(V_[1][i], pb, o1, 0, 0, 0); } } while (0)
        float carry = 0.f;
        if (nt > 0) {
            CMP_LOADK(kA, 0); CMP_LOADV(vA, 0);
#pragma unroll 1
            for (int t = 0;; t += 2) {
                { const int tn = t + 1 < nt ? t + 1 : nt - 1; CMP_LOADK(kB, tn); CMP_LOADV(vB, tn); } CMP_P2(kA, vA, t); if (t + 1 >= nt) break;
                { const int tn = t + 2 < nt ? t + 2 : nt - 1; CMP_LOADK(kA, tn); CMP_LOADV(vA, tn); } CMP_P2(kB, vB, t + 1); if (t + 2 >= nt) break;
            }
        }
#undef CMP_LOADK
#undef CMP_LOADV
#undef CMP_P1
#undef CMP_P2
        if (nt > 0 && nt < 8 && hi == 0) imps[r32 * 65 + 8 * nt] = carry;
        const float g0 = sigmoidf_(ZS[(rowb + tq) * 16 + 4 + h * 3 + 0]);
        store_ot_bf16((bf16*)(a->ws + WS_OCB) + (rowb + tq) * 256 + h * 64, o0, o1, g0, hi);
    }
    asm volatile("s_waitcnt lgkmcnt(0)" ::: "memory");
}
__device__ __forceinline__ void fa_cmp_topk(CArgsP a, int b, int qt, LAS float* imps, LAS unsigned long long* kl  , int tok0, int ntok, int lane_in) {
    int lane = lane_in; asm volatile("" : "+v"(lane));
    unsigned long long mymask = 0ull; const int curb = qt >> 1;
    const bool causal = lane <= curb; const bool forced = (lane == 0) || (lane == curb) || (lane == curb - 1);
    if (curb < 16) { if (lane < ntok) ((unsigned long long*)(a->ws + WS_MASK))[(size_t)b * SEQ + qt * 32 + tok0 + lane] = (2ull << curb) - 1ull; return; }
    for (int tt = tok0; tt < tok0 + ntok; tt += 2) {
        const float impA = (imps[tt * 65 + lane] + imps[2080 + tt * 65 + lane]) + (imps[2 * 2080 + tt * 65 + lane] + imps[3 * 2080 + tt * 65 + lane]);
        const float impB = (imps[(tt + 1) * 65 + lane] + imps[2080 + (tt + 1) * 65 + lane]) + (imps[2 * 2080 + (tt + 1) * 65 + lane] + imps[3 * 2080 + (tt + 1) * 65 + lane]);
        const unsigned long long keyA = causal ? (((unsigned long long)(forced ? 0x7f800000u : __float_as_uint(impA)) << 32) | (unsigned)(63 - lane)) : 0ull;
        const unsigned long long keyB = causal ? (((unsigned long long)(forced ? 0x7f800000u : __float_as_uint(impB)) << 32) | (unsigned)(63 - lane)) : 0ull;
        kl[lane] = keyA; kl[64 + lane] = keyB;
        int rankA = 0, rankB = 0;
#pragma unroll 2
        for (int jj = 0; jj <= curb; jj += 2) { const v4u twoA = *(const LAS v4u*)(kl + jj), twoB = *(const LAS v4u*)(kl + 64 + jj);
            const unsigned long long a0 = ((unsigned long long)twoA.y << 32) | twoA.x, a1 = ((unsigned long long)twoA.w << 32) | twoA.z;
            const unsigned long long b0 = ((unsigned long long)twoB.y << 32) | twoB.x, b1 = ((unsigned long long)twoB.w << 32) | twoB.z;
            rankA += (a0 > keyA) ? 1 : 0; rankA += (a1 > keyA) ? 1 : 0; rankB += (b0 > keyB) ? 1 : 0; rankB += (b1 > keyB) ? 1 : 0; }
        const unsigned long long mkA = __ballot(rankA < 16 && causal), mkB = __ballot(rankB < 16 && causal);
        if (lane == tt - tok0) mymask = mkA;
        if (lane == tt + 1 - tok0) mymask = mkB;
    }
    if (lane < ntok) ((unsigned long long*)(a->ws + WS_MASK))[(size_t)b * SEQ + qt * 32 + tok0 + lane] = mymask;
    asm volatile("s_waitcnt lgkmcnt(0)" ::: "memory");
}
struct SlcF { int tq; unsigned long long mask; float slope2; bool bit;
    static constexpr bool LINEAR = false;
    __device__ __forceinline__ float lin_bias() const { return 0.f; }
    __device__ __forceinline__ void begin_tile(int k0) { bit = (mask >> (k0 >> 6)) & 1ull; }
    __device__ __forceinline__ bool tile_masked(bool diag) const { return diag || !__all(bit); }
    __device__ __forceinline__ float plain(int key, float raw) const { return raw * C2S - slope2 * (float)(tq - key); }
    __device__ __forceinline__ bool valid(int key) const { return bit && key <= tq; } };
struct SlcIt { unsigned long long um; int qt;
    __device__ __forceinline__ int first() const { return um ? 2 * (int)__builtin_ctzll(um) : -1; }
    __device__ __forceinline__ int next(int t) const { if ((t & 1) == 0 && t + 1 <= qt) return t + 1; const int j = t >> 1; if (j >= 63) return -1; const unsigned long long rem = um >> (j + 1); return rem ? 2 * (j + 1 + (int)__builtin_ctzll(rem)) : -1; }
    __device__ __forceinline__ bool masked(int t) const { return t == qt; }
    __device__ __forceinline__ bool block_ok(int) const { return false; }
    __device__ __forceinline__ int clampt(int t) const { return t; } };
__device__ __forceinline__ void fa_nsa_item(CArgsP a, int bh, int qt, int lane_in) {
    int lane = lane_in; asm volatile("" : "+v"(lane));
    const int b = bh >> 2, h = bh & 3, r32 = lane & 31, hi = lane >> 5; const int tq = qt * 32 + r32; const size_t rowb = (size_t)b * SEQ;
    const bf16* Z = (const bf16*)(a->ws + WS_ZH); const float* ZS = (const float*)(a->ws + WS_ZS);
    const float slope2 = alibi_slope(4 + h) * LOG2E;
    bf16x8 qf[4]; load_frag4(qf, Z + (rowb + tq) * ZP + ZQ_NSA + h * 64, hi);
    const unsigned long long mask = ((const unsigned long long*)(a->ws + WS_MASK))[rowb + tq];
    const float g1 = sigmoidf_(ZS[(rowb + tq) * 16 + 4 + h * 3 + 1]), g2 = sigmoidf_(ZS[(rowb + tq) * 16 + 4 + h * 3 + 2]);
    const bf16* oc = (const bf16*)(a->ws + WS_OCB) + (rowb + tq) * 256 + h * 64; bf16* ob = (bf16*)(a->ws + WS_O) + (rowb + tq) * DM + (4 + h) * 64;
    {
        FA st; fa_init(st);
        const bf16* vtl = (const bf16*)(a->ws + WS_VF_NS) + (size_t)b * 128 * 2048; const bf16* Kb = (const bf16*)(a->ws + WS_KF_NS) + (size_t)b * 128 * 2048;
        const SlcF f{tq, mask, slope2, false};
        const int curb = qt >> 1; unsigned long long um = 0ull;
        for (int j = 0; j <= curb; ++j) if (__any((mask >> j) & 1ull)) um |= 1ull << j;
        fa_stream<false, true, true>(st, qf, Kb, (size_t)ZP, vtl, (size_t)SEQ, nullptr, SlcIt{um, qt}, r32, hi, f);
        const float l = st.l + __shfl_xor(st.l, 32); const float sc = g1 / fmaxf(l, 1e-30f);
        store_ot_bf16(ob, st.o0, st.o1, sc, hi);
    }
    asm volatile("" ::: "memory");
    {
        FA st; fa_init(st);
        const bf16* vtl = (const bf16*)(a->ws + WS_VF_NW) + (size_t)b * 128 * 2048;
        int tlo = qt * 32 - 511; tlo = tlo < 0 ? 0 : tlo >> 5;
        fa_stream<false, true, true>(st, qf, (const bf16*)(a->ws + WS_KF_NW) + (size_t)b * 128 * 2048, (size_t)ZP, vtl, (size_t)SEQ, nullptr, RangeIt{tlo, qt, band_tfull(qt * 32, 511)}, r32, hi, BandF{tq, 511, slope2});
        const float l = st.l + __shfl_xor(st.l, 32); const float sc = g2 / l;
#pragma unroll
        for (int a4 = 0; a4 < 4; ++a4) { const u32x2_t x = *(const u32x2_t*)(oc + 8 * a4 + 4 * hi), y = *(const u32x2_t*)(oc + 32 + 8 * a4 + 4 * hi);
            const u32x2_t x2 = *(const u32x2_t*)(ob + 8 * a4 + 4 * hi), y2 = *(const u32x2_t*)(ob + 32 + 8 * a4 + 4 * hi);
            st.o0[4 * a4] = st.o0[4 * a4] * sc + (bflo(x.x) + bflo(x2.x)); st.o0[4 * a4 + 1] = st.o0[4 * a4 + 1] * sc + (bfhi(x.x) + bfhi(x2.x)); st.o0[4 * a4 + 2] = st.o0[4 * a4 + 2] * sc + (bflo(x.y) + bflo(x2.y)); st.o0[4 * a4 + 3] = st.o0[4 * a4 + 3] * sc + (bfhi(x.y) + bfhi(x2.y));
            st.o1[4 * a4] = st.o1[4 * a4] * sc + (bflo(y.x) + bflo(y2.x)); st.o1[4 * a4 + 1] = st.o1[4 * a4 + 1] * sc + (bfhi(y.x) + bfhi(y2.x)); st.o1[4 * a4 + 2] = st.o1[4 * a4 + 2] * sc + (bflo(y.y) + bflo(y2.y)); st.o1[4 * a4 + 3] = st.o1[4 * a4 + 3] * sc + (bfhi(y.y) + bfhi(y2.y)); }
        store_ot_bf16(ob, st.o0, st.o1, 1.0f, hi);
    }
}
#define GAS __attribute__((address_space(1)))
typedef GAS unsigned gu32;
#define XB_TMO      128
#define XB_XCNT(j)  (256  + 64 * (j))
#define XB_XSUB(j)  (1280 + 64 * (j))
#define XB_XGEN(j)  (2304 + 64 * (j))
#define XB_TOP      3328
#define XB_TOPGEN   3392
#define XCD_BAR_WORDS 3456
#define XB_SPIN_CAP (1u << 18)

__device__ __forceinline__ unsigned xb_ld(unsigned* p)              { return __hip_atomic_load(p, __ATOMIC_RELAXED, __HIP_MEMORY_SCOPE_AGENT); }
__device__ __forceinline__ unsigned xb_add(unsigned* p, unsigned v) { return __hip_atomic_fetch_add(p, v, __ATOMIC_RELAXED, __HIP_MEMORY_SCOPE_AGENT); }
__device__ __forceinline__ unsigned xb_xcc_id() { return (unsigned)__builtin_amdgcn_s_getreg((3 << 11) | 20) & 0xFu; }
#define XB_SPIN(cond, bar) do { unsigned _sp = 0; while (cond) { __builtin_amdgcn_s_sleep(1); \
    if ((++_sp & 255u) == 0u) { if (xb_ld(&(bar)[XB_TMO])) break; if (_sp > XB_SPIN_CAP) { atomicAdd(&(bar)[XB_TMO], 1u); break; } } } } while (0)

struct XcdBarrier {
    unsigned* bar; unsigned x;
    volatile LAS unsigned* st;
};

__device__ __forceinline__ XcdBarrier xcd_barrier_post(unsigned* bar, volatile LAS unsigned* st) {
    XcdBarrier b; b.bar = bar; b.x = xb_xcc_id(); b.st = st;
    if (threadIdx.x == 0) (void)xb_add(&bar[XB_XCNT(b.x)], 1u);
    return b;
}
__device__ __forceinline__ void xcd_barrier_complete(unsigned* bar, unsigned x, unsigned& nloc, unsigned& nx) {
    const unsigned G = gridDim.x * gridDim.y * gridDim.z;
    unsigned sum, cnt, mine, sp = 0u;
    for (;;) {
        sum = 0u; cnt = 0u; mine = 0u;
#pragma unroll
        for (unsigned j = 0; j < 16; ++j) { const unsigned c = xb_ld(&bar[XB_XCNT(j)]); sum += c; cnt += (c > 0u) ? 1u : 0u; mine = (j == x) ? c : mine; }
        if (sum == G) break;
        __builtin_amdgcn_s_sleep(1);
        if ((++sp & 255u) == 0u) { if (xb_ld(&bar[XB_TMO])) break; if (sp > XB_SPIN_CAP) { atomicAdd(&bar[XB_TMO], 1u); break; } }
    }
    nloc = mine > 0u ? mine : 1u; nx = cnt > 0u ? cnt : 1u;
}

__device__ __forceinline__ void xcd_barrier(const XcdBarrier& b) {
    asm volatile("s_waitcnt vmcnt(0)" ::: "memory");
    __syncthreads();
    if (threadIdx.x == 0) {
        unsigned* bar = b.bar;
        __builtin_amdgcn_s_waitcnt(0);
        unsigned nloc = b.st[0], nx = b.st[1];
        if (nloc == 0u) { xcd_barrier_complete(bar, b.x, nloc, nx); b.st[0] = nloc; b.st[1] = nx; }
        const unsigned old = xb_add(&bar[XB_XSUB(b.x)], 1u);
        const unsigned gen = old / nloc;
        if (old + 1u == (gen + 1u) * nloc) {
            __builtin_amdgcn_fence(__ATOMIC_RELEASE, "agent");
            asm volatile("s_waitcnt vmcnt(0)" ::: "memory");
            const unsigned og = xb_add(&bar[XB_TOP], 1u);
            const unsigned tg = og / nx;
            if (og + 1u == (tg + 1u) * nx) xb_add(&bar[XB_TOPGEN], 1u);
            else XB_SPIN(xb_ld(&bar[XB_TOPGEN]) == tg, bar);
            __builtin_amdgcn_fence(__ATOMIC_ACQUIRE, "agent");
            xb_add(&bar[XB_XGEN(b.x)], 1u);
            asm volatile("s_waitcnt vmcnt(0)" ::: "memory");
        } else {
            XB_SPIN(xb_ld(&bar[XB_XGEN(b.x)]) == gen, bar);
            __builtin_amdgcn_fence(__ATOMIC_ACQUIRE, "agent");
            asm volatile("s_waitcnt vmcnt(0)" ::: "memory");
        }
    }
    __syncthreads();
}

constexpr size_t WS_BAR = WS_DL + 1536 * 1024;
static_assert(WS_BAR + XCD_BAR_WORDS * 4 <= WS_END, "barrier words inside the small region");
constexpr int LDS_BARST = LDS_BYTES - 64;
#define GRID_BAR() do { CArgsP bp_ = (CArgsP)__builtin_amdgcn_kernarg_segment_ptr(); asm volatile("" : "+s"(bp_)); XcdBarrier xb_; xb_.bar = (unsigned*)(bp_->ws + WS_BAR); xb_.x = xb_xcc_id(); \
    xb_.st = (volatile LAS unsigned*)(lds + LDS_BARST); xcd_barrier(xb_); } while (0)
#define PHASE_ARGS() asm volatile("; PHASE_MARK line %0" :: "i"(__LINE__)); CArgsP ap_ = (CArgsP)__builtin_amdgcn_kernarg_segment_ptr(); asm volatile("" : "+s"(ap_)); \
    CArgsP a = ap_; unsigned char* ws = a->ws; bf16* ZH = (bf16*)(ws + WS_ZH); bf16* XG = (bf16*)(ws + WS_XG); bf16* OB = (bf16*)(ws + WS_O); float* SSQ = (float*)(ws + WS_SSQ); float* ZS = (float*)(ws + WS_ZS); float* X = a->out; \
    (void)ZH; (void)XG; (void)OB; (void)SSQ; (void)ZS; (void)X; int ln = threadIdx.x; asm volatile("" : "+v"(ln)); ln &= 63;
__global__ void __launch_bounds__(NTHR, 2) fwd_megakernel(Args a_unused) {
    extern __shared__ __attribute__((aligned(16))) unsigned char lds_raw[];
    LAS unsigned char* lds = (LAS unsigned char*)lds_raw;
    const int wave = __builtin_amdgcn_readfirstlane(threadIdx.x >> 6);
    const int G = gridDim.x, gw = blockIdx.x * NWAVES + wave, NGW = G * NWAVES;
    const int vcu = (G % 8 == 0) ? (int)(blockIdx.x % 8) * (G / 8) + (int)(blockIdx.x / 8) : (int)blockIdx.x;
    const int gv = vcu * NWAVES + wave;

    if (threadIdx.x < 2) ((LAS unsigned*)(lds + LDS_BARST))[threadIdx.x] = 0u;
    __syncthreads();
    { CArgsP bp_ = (CArgsP)__builtin_amdgcn_kernarg_segment_ptr(); (void)xcd_barrier_post((unsigned*)(bp_->ws + WS_BAR), (volatile LAS unsigned*)(lds + LDS_BARST)); }
    for (int rp = 0; rp < REP_PRO; ++rp)
    { PHASE_ARGS(); prologue(a, lds, gw, NGW, wave, ln); }
    cg::this_grid().sync();

    for (int l = 0; l < DEPTH; ++l) {
        const size_t wlo = WS_W + (size_t)l * LAYER_W;
#if GSEL & 1
        for (int rep = 0; rep < REP_G1; ++rep)
        { PHASE_ARGS(); pg8::Gemm g{XG, (const bf16*)(ws + wlo + OFF_WGU1), M, NGU, DM}; pg8::StaticOrder S; S.init(M, NGU, G, (int)blockIdx.x);
          pg8::EpiSwiglu E{ZH, SSQ, DFF};
          pg8::gemm_phase<pg8::EpiSwiglu, pg8::StaticOrder, true, true>(lds, g, S, E); }
#endif
        GRID_BAR();
#if GSEL & 2
        { PHASE_ARGS(); pg8::Gemm g{ZH, (const bf16*)(ws + wlo + OFF_WD1), M, DM, DFF}; pg8::StaticOrder S; S.init(M, DM, G, (int)blockIdx.x);
          pg8::EpiResid E{l == 0 ? a->in[0] : X, X, XG, a->in[5] + l * DM, SSQ, 0.5f};
          pg8::gemm_phase<pg8::EpiResid, pg8::StaticOrder, true, true>(lds, g, S, E); }
#endif
        GRID_BAR();
#if GSEL & 4
        { PHASE_ARGS(); pg8::Gemm g{XG, (const bf16*)(ws + wlo + OFF_WIN), M, ZP, DM}; pg8::StaticOrder S; S.init(M, ZP, G, (int)blockIdx.x);
          pg8::EpiZ E{ZH, ZS, SSQ, ZP};
          pg8::gemm_phase<pg8::EpiZ, pg8::StaticOrder, true, true>(lds, g, S, E); }
#endif
        GRID_BAR();
        for (int rep = 0; rep < REP_P4; ++rep) {
        { PHASE_ARGS();
          for (int it = blockIdx.x; it < 32 + 256; it += G) { if (it < 32) p4_cumsum(a, l, lds, it); else p4_compress(a, l, lds, it - 32); }
          for (int it = gw; it < 14336; it += NGW) p4_vfrag2_item(a, it, (LAS unsigned short*)(lds + wave * 16640), ln);
          for (int it = gw; it < 6144; it += NGW) { p4_kfrag_item(a, it, ln); p4_vfrag_item(a, it, (LAS unsigned short*)(lds + wave * 16640), ln); }
#if !FA_DIL
          for (int it = gw; it < 6144; it += NGW) p4_dil_item(a, it, ln);
#endif
#if !FA_SWA
          for (int it = gw; it < 2048; it += NGW) p4_swa_item(a, l, it, ln);
#endif
        }
        GRID_BAR(); }
        for (int rep = 0; rep < REP_P5; ++rep) {
        { PHASE_ARGS();
#if FA_FOX
          for (int rp = 0; rp < REP_FOX; ++rp)
          for (int i = gv; i < 2048; i += NGW) { fa_fox_item(a, i >> 6, 127 - (i & 63), ln); fa_fox_item(a, i >> 6, i & 63, ln); }
#else
          for (int it = gw; it < 2048; it += NGW) p5_fox_item(a, it, ln);
#endif
#if FA_CMP
          for (int rp = 0; rp < REP_CMP; ++rp)
          for (int rd = vcu; rd < 256; rd += G) {
              const int cb = rd >> 5, ck = rd & 31, slot = wave >> 1, hp = wave & 1;
#define CMP_QT(s_) ((s_) == 0 ? ck : ((s_) == 1 ? 63 - ck : ((s_) == 2 ? 64 + ck : 127 - ck)))
              const int cqt = CMP_QT(slot);
              LAS float* imps = (LAS float*)(lds + slot * 4 * 8320);
              for (int rq = 0; rq < REP_CPASS; ++rq)
              { const int hh = wave & 3, s1 = wave < 4 ? 3 : 2, s2 = wave < 4 ? 0 : 1;
                fa_cmp_passes(a, cb, CMP_QT(s1), hh, hh + 1, (LAS float*)(lds + (s1 * 4 + hh) * 8320), ln);
                fa_cmp_passes(a, cb, CMP_QT(s2), hh, hh + 1, (LAS float*)(lds + (s2 * 4 + hh) * 8320), ln); }
#undef CMP_QT
              __syncthreads();
              for (int rq = 0; rq < REP_CTOPK; ++rq) fa_cmp_topk(a, cb, cqt, imps, (LAS unsigned long long*)(lds + 133120 + wave * 1024), 16 * hp, 16, ln);
              __syncthreads();
          }
#else
          for (int it = gw; it < 512; it += NGW) p5_cmp_item(a, it, (LAS float*)(lds + wave * 16640), ln);
#endif
#if FA_SWA
          for (int it = gv; it < 4096; it += NGW) fa_swa_item(a, l, it, ln);
#endif
#if FA_DIL
          for (int rp = 0; rp < REP_DIL; ++rp)
          for (int it = gv; it < 12288; it += NGW) fa_dil_item(a, it, ln);
#else
          for (int it = gw; it < 2048; it += NGW) p5_dilcomb_item(a, it, ln);
#endif
        }
        GRID_BAR(); }
        for (int rep = 0; rep < REP_P6; ++rep) {
        { PHASE_ARGS();
#if FA_NSA
          for (int i = gv; i < 2048; i += NGW) { fa_nsa_item(a, i >> 6, 127 - (i & 63), ln); fa_nsa_item(a, i >> 6, i & 63, ln); }
#else
          for (int it = gw; it < 2048; it += NGW) p6_nsa_item(a, it, ln);
#endif
#if FA_DIL
          for (int it = gw; it < 2048; it += NGW) p5_dilcomb_item(a, it, ln);
#endif
        }
        GRID_BAR(); }
#if GSEL & 8
        { PHASE_ARGS(); pg8::Gemm g{OB, (const bf16*)(ws + wlo + OFF_WOUT), M, DM, DM}; pg8::StaticOrder S; S.init(M, DM, G, (int)blockIdx.x);
          pg8::EpiResid E{X, X, XG, a->in[13] + l * DM, SSQ, 1.0f};
          pg8::gemm_phase<pg8::EpiResid, pg8::StaticOrder, true, true>(lds, g, S, E); }
#endif
        GRID_BAR();
#if GSEL & 1
        { PHASE_ARGS(); pg8::Gemm g{XG, (const bf16*)(ws + wlo + OFF_WGU2), M, NGU, DM}; pg8::StaticOrder S; S.init(M, NGU, G, (int)blockIdx.x);
          pg8::EpiSwiglu E{ZH, SSQ, DFF};
          pg8::gemm_phase<pg8::EpiSwiglu, pg8::StaticOrder, true, true>(lds, g, S, E); }
#endif
        GRID_BAR();
#if GSEL & 2
        { PHASE_ARGS(); pg8::Gemm g{ZH, (const bf16*)(ws + wlo + OFF_WD2), M, DM, DFF}; pg8::StaticOrder S; S.init(M, DM, G, (int)blockIdx.x);
          pg8::EpiResid E{X, X, XG, l + 1 < DEPTH ? a->in[1] + (l + 1) * DM : a->in[17], SSQ, 0.5f};
          pg8::gemm_phase<pg8::EpiResid, pg8::StaticOrder, true, true>(lds, g, S, E); }
#endif
        GRID_BAR();
    }
#ifdef EXTRA_SYNCS
    for (int i = 0; i < EXTRA_SYNCS; ++i) GRID_BAR();
#endif
    { PHASE_ARGS(); const int lane = ln; const float* gf = a->in[17]; f32x4 gv[4];
#pragma unroll
      for (int j = 0; j < 4; ++j) gv[j] = *(const f32x4*)(gf + 4 * lane + 256 * j);
      for (int m = gw; m < M; m += NGW) {
          const f32x4 p = *(const f32x4*)(SSQ + (size_t)m * 16 + 4 * (lane & 3)); float s = (p[0] + p[1]) + (p[2] + p[3]); s += __shfl_xor(s, 1); s += __shfl_xor(s, 2);
          const float rs = 1.0f / sqrtf(s * (1.0f / 1024.0f) + 1e-6f);
          f32x4* xr = (f32x4*)(X + (size_t)m * DM) + lane;
#pragma unroll
          for (int j = 0; j < 4; ++j) { f32x4 v = xr[64 * j]; v = v * gv[j] * rs; xr[64 * j] = v; } } }
}

extern "C" void kernel_launch(void* const* d_in, const int* in_sizes, int n_in, void* d_out, int out_size, void* d_ws, size_t ws_size, hipStream_t stream) {
    static int grid = 0;
    if (grid == 0) {
        if (n_in != 18 || out_size != M * DM || ws_size < 512 * MiB) { fprintf(stderr, "kernel_launch: unexpected shapes (n_in %d out %d ws %zu)\n", n_in, out_size, ws_size); grid = -1; return; }
        int dev = 0, cus = 0, per_cu = 0;
        (void)hipGetDevice(&dev); (void)hipDeviceGetAttribute(&cus, hipDeviceAttributeMultiprocessorCount, dev);
        if (hipFuncSetAttribute((const void*)fwd_megakernel, hipFuncAttributeMaxDynamicSharedMemorySize, LDS_BYTES) != hipSuccess) { fprintf(stderr, "hipFuncSetAttribute failed\n"); grid = -1; return; }
        if (hipOccupancyMaxActiveBlocksPerMultiprocessor(&per_cu, (const void*)fwd_megakernel, NTHR, LDS_BYTES) != hipSuccess || per_cu < 1) { fprintf(stderr, "occupancy query: %d\n", per_cu); per_cu = 1; }
        (void)hipGetLastError();
        grid = cus;
        if (grid <= 0) grid = 256;
    }
    if (grid < 0) return;
    if (hipMemsetAsync((char*)d_ws + WS_BAR, 0, XCD_BAR_WORDS * 4, stream) != hipSuccess) { fprintf(stderr, "memset of the barrier words failed\n"); return; }
    Args a{};
    for (int i = 0; i < 18; ++i) a.in[i] = (const float*)d_in[i];
    a.out = (float*)d_out; a.ws = (unsigned char*)d_ws;
    void* args[] = {&a};
    hipError_t e = hipLaunchCooperativeKernel((const void*)fwd_megakernel, dim3(grid), dim3(NTHR), args, LDS_BYTES, stream);
    if (e != hipSuccess) fprintf(stderr, "cooperative launch failed: %s (grid %d)\n", hipGetErrorString(e), grid);
}
```

```cpp
#include <hip/hip_runtime.h>
#include <cstdio>
#include <cstdint>
#include <cmath>
namespace pg8 {
#define PG8_LAS __attribute__((address_space(3)))
typedef unsigned short bf16_t;
typedef short bf16x8 __attribute__((ext_vector_type(8)));
typedef float f32x4 __attribute__((ext_vector_type(4)));
typedef unsigned u32x4 __attribute__((ext_vector_type(4)));
constexpr int BM = 256, BK = 64, HALF = 128, HTB = HALF * BK * 2  , STAGE_BYTES = 8 * HTB, NXCD = 8, WGM = 8;

__host__ __device__ __forceinline__ int lds_byte(int r, int c) { const int st = (r >> 4) * 2 + (c >> 5), rr = r & 15, cc = c & 31, ob = rr * 64 + cc * 2; return st * 1024 + (ob ^ (((ob >> 9) & 1) << 5)); }
__host__ __device__ __forceinline__ void stage_rc(int b, int& R, int& C) { const int st = b / 1024, sb = b % 1024, swz = sb ^ (((sb >> 9) & 1) << 5); R = (st >> 1) * 16 + swz / 64; C = (st & 1) * 32 + (swz % 64) / 2; }
__host__ __device__ __forceinline__ int perm32(int rho) { const int n = rho >> 4, i = rho & 15; return 8 * (i >> 2) + 4 * n + (i & 3); }

struct Unit { int pm, pn; };
struct Gemm { const bf16_t* A; const bf16_t* Bt; int M, N, K; };

struct StaticOrder {
    int nM, nN, nwg, G, c;
    __host__ __device__ void init(int M, int N, int G_, int c_) { nM = M / BM; nN = N / BM; nwg = nM * nN; G = G_; c = c_; }
    __host__ __device__ bool next(int i, Unit& u) const {
        const long L = (long)i * G + c; if (L >= nwg) return false;
        int wgid = (int)L; { const int q = nwg / NXCD, r = nwg % NXCD, xcd = wgid % NXCD, off = wgid / NXCD; wgid = (xcd < r ? xcd * (q + 1) : r * (q + 1) + (xcd - r) * q) + off; }
        const int nig = WGM * nN, gid = wgid / nig, fm = gid * WGM, gsz = (nM - fm) < WGM ? (nM - fm) : WGM;
        u.pm = fm + ((wgid % nig) % gsz); u.pn = (wgid % nig) / gsz; return true;
    }
    __device__ __forceinline__ void a_ready(const Unit&) const {}
    __device__ __forceinline__ void done(const Unit&) const {}
};

__device__ __forceinline__ unsigned cvt_pk_bf16(float lo, float hi) { unsigned r; asm volatile("v_cvt_pk_bf16_f32 %0, %1, %2" : "=v"(r) : "v"(lo), "v"(hi)); return r; }
typedef float f32x2 __attribute__((ext_vector_type(2)));
constexpr float RMS_EPS_F = 1e-6f;
typedef unsigned u32x2 __attribute__((ext_vector_type(2)));
__device__ __forceinline__ float row_rstd(const float* ssq, int row, int fq) {
    const f32x4 p = *(const f32x4*)(ssq + (size_t)row * 16 + 4 * fq);
    float s = (p[0] + p[1]) + (p[2] + p[3]);
    s += __shfl_xor(s, 16); s += __shfl_xor(s, 32);
    return 1.0f / sqrtf(s * (1.0f / 1024.0f) + RMS_EPS_F);
}
__device__ __forceinline__ void row_rstd8(float (&rs)[2][4], const float* ssq, int row0, int fq) {
    f32x4 p[2][4];
#pragma unroll
    for (int ai = 0; ai < 2; ++ai)
#pragma unroll
        for (int m = 0; m < 4; ++m) p[ai][m] = *(const f32x4*)(ssq + (size_t)(row0 + ai * HALF + m * 16) * 16 + 4 * fq);
#pragma unroll
    for (int ai = 0; ai < 2; ++ai)
#pragma unroll
        for (int m = 0; m < 4; ++m) { float s = (p[ai][m][0] + p[ai][m][1]) + (p[ai][m][2] + p[ai][m][3]); s += __shfl_xor(s, 16); s += __shfl_xor(s, 32); rs[ai][m] = 1.0f / sqrtf(s * (1.0f / 1024.0f) + RMS_EPS_F); }
}
__device__ __forceinline__ float silu_mul(float g, float u) { return g * u * __builtin_amdgcn_rcpf(1.0f + __expf(-g)); }
struct EpiSwiglu {
    static constexpr bool PERM = true, AFTER_DRAIN = false;
    bf16_t* H; const float* ssq; int ldh;
    __device__ __forceinline__ void operator()(const f32x4 (&acc)[2][2][4][2], const Unit& u, int wr, int wc, int fr, int fq) const {
        const int row0 = u.pm * BM + wr * 64 + fr; const int col0 = u.pn * HALF + wc * 32 + 8 * fq;
        float rsv[2][4]; row_rstd8(rsv, ssq, row0, fq);
#pragma unroll
        for (int ai = 0; ai < 2; ++ai)
#pragma unroll
            for (int m = 0; m < 4; ++m) {
                const int row = row0 + ai * HALF + m * 16; const float rs = rsv[ai][m];
                const f32x4 g0 = acc[ai][0][m][0] * rs, g1 = acc[ai][0][m][1] * rs, u0 = acc[ai][1][m][0] * rs, u1 = acc[ai][1][m][1] * rs;
                u32x4 w; w.x = cvt_pk_bf16(silu_mul(g0[0], u0[0]), silu_mul(g0[1], u0[1])); w.y = cvt_pk_bf16(silu_mul(g0[2], u0[2]), silu_mul(g0[3], u0[3]));
                w.z = cvt_pk_bf16(silu_mul(g1[0], u1[0]), silu_mul(g1[1], u1[1])); w.w = cvt_pk_bf16(silu_mul(g1[2], u1[2]), silu_mul(g1[3], u1[3]));
                *(u32x4*)(H + (size_t)row * ldh + col0) = w;
            }
    }
};
struct EpiResid {
    static constexpr bool PERM = true, AFTER_DRAIN = false;
    const float* base; float* xout; bf16_t* XG; const float* gnext; float* ssq; float alpha;
    __device__ __forceinline__ void operator()(const f32x4 (&acc)[2][2][4][2], const Unit& u, int wr, int wc, int fr, int fq) const {
        const int row0 = u.pm * BM + wr * 64 + fr; const int col0 = u.pn * BM + wc * 32 + 8 * fq;
        f32x4 gv[2][2];
#pragma unroll
        for (int bj = 0; bj < 2; ++bj)
#pragma unroll
            for (int n = 0; n < 2; ++n) gv[bj][n] = *(const f32x4*)(gnext + col0 + bj * HALF + 4 * n);
#pragma unroll
        for (int ai = 0; ai < 2; ++ai)
#pragma unroll
            for (int m = 0; m < 4; ++m) {
                const int row = row0 + ai * HALF + m * 16; float ss = 0.f;
#pragma unroll
                for (int bj = 0; bj < 2; ++bj) {
                    const size_t off = (size_t)row * 1024 + col0 + bj * HALF;
                    const f32x4 b0 = *(const f32x4*)(base + off), b1 = *(const f32x4*)(base + off + 4);
                    const f32x4 v0 = b0 + acc[ai][bj][m][0] * alpha, v1 = b1 + acc[ai][bj][m][1] * alpha;
                    *(f32x4*)(xout + off) = v0; *(f32x4*)(xout + off + 4) = v1;
                    ss += (v0[0] * v0[0] + v0[1] * v0[1]) + (v0[2] * v0[2] + v0[3] * v0[3]) + (v1[0] * v1[0] + v1[1] * v1[1]) + (v1[2] * v1[2] + v1[3] * v1[3]);
                    const f32x4 y0 = v0 * gv[bj][0], y1 = v1 * gv[bj][1];
                    u32x4 w; w.x = cvt_pk_bf16(y0[0], y0[1]); w.y = cvt_pk_bf16(y0[2], y0[3]); w.z = cvt_pk_bf16(y1[0], y1[1]); w.w = cvt_pk_bf16(y1[2], y1[3]);
                    *(u32x4*)(XG + off) = w;
                }
                ss += __shfl_xor(ss, 16); ss += __shfl_xor(ss, 32);
                if (fq == 0) ssq[(size_t)row * 16 + u.pn * 4 + wc] = ss;
                if (m & 1) asm volatile("" ::: "memory");
            }
    }
};
struct EpiZ {
    static constexpr bool PERM = true, AFTER_DRAIN = false;
    bf16_t* Z; float* ZS; const float* ssq; int ldz; bf16_t* KF;
    __device__ __forceinline__ void operator()(const f32x4 (&acc)[2][2][4][2], const Unit& u, int wr, int wc, int fr, int fq) const {
        const int row0 = u.pm * BM + wr * 64 + fr; const int col0 = u.pn * BM + wc * 32 + 8 * fq;
        const bool small = (u.pn == 10) && (wc == 0) && (fq < 2);
        float rsv[2][4]; row_rstd8(rsv, ssq, row0, fq);
#pragma unroll
        for (int ai = 0; ai < 2; ++ai)
#pragma unroll
            for (int m = 0; m < 4; ++m) {
                const int row = row0 + ai * HALF + m * 16; const float rs = rsv[ai][m];
#pragma unroll
                for (int bj = 0; bj < 2; ++bj) {
                    const f32x4 v0 = acc[ai][bj][m][0] * rs, v1 = acc[ai][bj][m][1] * rs;
                    u32x4 w; w.x = cvt_pk_bf16(v0[0], v0[1]); w.y = cvt_pk_bf16(v0[2], v0[3]); w.z = cvt_pk_bf16(v1[0], v1[1]); w.w = cvt_pk_bf16(v1[2], v1[3]);
                    if (u.pn == 1) { const int cc = bj * HALF + wc * 32 + 8 * fq, tk = row & 4095;
                        *(u32x4*)(KF + ((size_t)(((row >> 12) * 4 + (cc >> 6)) * 128 + (tk >> 5)) * 2048) + ((((cc & 63) >> 3) * 32 + (tk & 31)) * 8)) = w; }
                    else *(u32x4*)(Z + (size_t)row * ldz + col0 + bj * HALF) = w;
                    if (bj == 1 && small) { *(f32x4*)(ZS + (size_t)row * 16 + 8 * fq) = v0; *(f32x4*)(ZS + (size_t)row * 16 + 8 * fq + 4) = v1; }
                }
            }
    }
};
template <class Epi, class Sched, bool ALIGN_EPI = false, bool SP2 = false>
__device__ __forceinline__ void gemm_phase(PG8_LAS unsigned char* lds, const Gemm g, const Sched& S, const Epi& E) {
    int tid_ = threadIdx.x; asm volatile("" : "+v"(tid_));
    const int tid = tid_, wid = __builtin_amdgcn_readfirstlane(tid >> 6), lane = tid & 63, wr = wid >> 2, wc = wid & 3, fr = lane & 15, fq = lane >> 4;
    const int K = g.K, nt = K / BK;
    unsigned voffA[2], voffB[2];
#pragma unroll
    for (int i = 0; i < 2; ++i) { int R, C; stage_rc(tid * 16 + i * 8192, R, C); const int Rb = Epi::PERM ? ((R & ~31) + perm32(R & 31)) : R;
        voffA[i] = (unsigned)(R * K + C) * 2u; voffB[i] = (unsigned)(Rb * K + C) * 2u; }
    const size_t kstep = (size_t)(BK * 2);
    const size_t hstep = (size_t)HALF * K * 2;
    const size_t tstep = 2 * hstep;
    const unsigned ldsw = (unsigned)wid * 1024u;
    const int aoff = lds_byte(wr * 64 + fr, fq * 8), boff = lds_byte(wc * 32 + fr, fq * 8);
#define PG8_SA(b, h) (((b) * 2 + (h)) * HTB)
#define PG8_SB(b, h) ((4 + (b) * 2 + (h)) * HTB)
#define PG8_STAGE(bufoff, gbase, voff) do { _Pragma("unroll") for (int _i = 0; _i < 2; ++_i) \
        __builtin_amdgcn_global_load_lds((const unsigned*)((const char*)(gbase) + (voff)[_i]), (PG8_LAS unsigned*)(lds + (bufoff) + ldsw + _i * 8192), 16, 0, 0); } while (0)
#define PG8_LDA(dst, b, h) do { _Pragma("unroll") for (int m = 0; m < 4; ++m) _Pragma("unroll") for (int k = 0; k < 2; ++k) dst[m][k] = *(const PG8_LAS bf16x8*)(lds + PG8_SA(b, h) + aoff + m * 2048 + k * 1024); } while (0)
#define PG8_LDB(dst, b, h) do { _Pragma("unroll") for (int n = 0; n < 2; ++n) _Pragma("unroll") for (int k = 0; k < 2; ++k) dst[n][k] = *(const PG8_LAS bf16x8*)(lds + PG8_SB(b, h) + boff + n * 2048 + k * 1024); } while (0)
#define PG8_MMA(ai, bj, At, Bt) do { __builtin_amdgcn_s_setprio(1); _Pragma("unroll") for (int m = 0; m < 4; ++m) _Pragma("unroll") for (int n = 0; n < 2; ++n) _Pragma("unroll") for (int k = 0; k < 2; ++k) \
        acc[ai][bj][m][n] = __builtin_amdgcn_mfma_f32_16x16x32_bf16(Bt[n][k], At[m][k], acc[ai][bj][m][n], 0, 0, 0); __builtin_amdgcn_s_setprio(0); } while (0)
#define PG8_WAIT_V(n) asm volatile("s_waitcnt vmcnt(" #n ")" ::: "memory")
#define PG8_WAIT_L(n) asm volatile("s_waitcnt lgkmcnt(" #n ")" ::: "memory")
#define PG8_BAR __builtin_amdgcn_s_barrier()
#define PG8_SCHED __builtin_amdgcn_sched_barrier(0)
    Unit cur, nxt; int ui = 0;
    if (!S.next(0, cur)) return;
    f32x4 acc[2][2][4][2];
#pragma unroll
    for (int a = 0; a < 2; ++a)
#pragma unroll
        for (int b = 0; b < 2; ++b)
#pragma unroll
            for (int m = 0; m < 4; ++m)
#pragma unroll
                for (int n = 0; n < 2; ++n) acc[a][b][m][n] = (f32x4){0.f, 0.f, 0.f, 0.f};
    bf16x8 At[4][2], B0[2][2], B1[2][2];
    const char* cA = (const char*)g.A + (size_t)cur.pm * tstep; const char* cB = (const char*)g.Bt + (size_t)cur.pn * tstep;
    S.a_ready(cur);
    if constexpr (SP2) {
        PG8_STAGE(PG8_SB(0, 0), cB, voffB); PG8_STAGE(PG8_SB(0, 1), cB + hstep, voffB); PG8_STAGE(PG8_SA(0, 0), cA, voffA); PG8_STAGE(PG8_SA(0, 1), cA + hstep, voffA);
        if (wr == 1) PG8_BAR;
        PG8_WAIT_V(2); PG8_BAR;
        PG8_STAGE(PG8_SB(1, 0), cB + kstep, voffB); PG8_STAGE(PG8_SA(1, 0), cA + kstep, voffA); PG8_STAGE(PG8_SB(1, 1), cB + hstep + kstep, voffB);
        PG8_WAIT_V(6); PG8_BAR;
    } else {
        PG8_STAGE(PG8_SB(0, 0), cB, voffB); PG8_STAGE(PG8_SA(0, 0), cA, voffA); PG8_STAGE(PG8_SB(0, 1), cB + hstep, voffB); PG8_STAGE(PG8_SA(0, 1), cA + hstep, voffA);
        if (wr == 1) PG8_BAR;
        PG8_WAIT_V(4); PG8_BAR;
        PG8_STAGE(PG8_SB(1, 0), cB + kstep, voffB); PG8_STAGE(PG8_SA(1, 0), cA + kstep, voffA); PG8_STAGE(PG8_SB(1, 1), cB + hstep + kstep, voffB);
        PG8_WAIT_V(6); PG8_BAR;
    }
    for (;;) {
        const bool has_next = S.next(ui + 1, nxt);
        const char* nA = has_next ? (const char*)g.A + (size_t)nxt.pm * tstep : cA; const char* nB = has_next ? (const char*)g.Bt + (size_t)nxt.pn * tstep : cB;
        for (int t = 0; t < nt; t += 2) {
            const bool last = (t == nt - 2);
            const char* a1 = cA + (size_t)(t + 1) * kstep;
            const char* a2 = last ? nA : cA + (size_t)(t + 2) * kstep; const char* b2 = last ? nB : cB + (size_t)(t + 2) * kstep;
            const char* a3 = a2 + kstep; const char* b3 = b2 + kstep;
            if (last && has_next) S.a_ready(nxt);
            if constexpr (SP2) {
            PG8_LDB(B0, 0, 0); PG8_LDB(B1, 0, 1); PG8_SCHED; PG8_LDA(At, 0, 0); PG8_STAGE(PG8_SA(1, 1), a1 + hstep, voffA);
            PG8_WAIT_V(8); PG8_WAIT_L(0); PG8_BAR; PG8_MMA(0, 0, At, B0); PG8_MMA(0, 1, At, B1); PG8_BAR; PG8_SCHED;
            PG8_LDA(At, 0, 1); PG8_STAGE(PG8_SB(0, 0), b2, voffB); PG8_STAGE(PG8_SB(0, 1), b2 + hstep, voffB); PG8_STAGE(PG8_SA(0, 0), a2, voffA);
            PG8_WAIT_V(8); PG8_WAIT_L(0); PG8_BAR; PG8_MMA(1, 0, At, B0); PG8_MMA(1, 1, At, B1); PG8_BAR; PG8_SCHED;
            PG8_LDB(B0, 1, 0); PG8_LDB(B1, 1, 1); PG8_SCHED; PG8_LDA(At, 1, 0); PG8_STAGE(PG8_SA(0, 1), a2 + hstep, voffA);
            PG8_WAIT_V(8); PG8_WAIT_L(0); PG8_BAR; PG8_MMA(0, 0, At, B0); PG8_MMA(0, 1, At, B1); PG8_BAR; PG8_SCHED;
            PG8_LDA(At, 1, 1); PG8_STAGE(PG8_SB(1, 0), b3, voffB); PG8_STAGE(PG8_SB(1, 1), b3 + hstep, voffB); PG8_STAGE(PG8_SA(1, 0), a3, voffA);
            PG8_WAIT_V(8); PG8_WAIT_L(0); PG8_BAR; PG8_MMA(1, 0, At, B0); PG8_MMA(1, 1, At, B1); PG8_BAR; PG8_SCHED;
            } else {
            PG8_LDB(B0, 0, 0); PG8_SCHED; PG8_LDA(At, 0, 0); PG8_STAGE(PG8_SA(1, 1), a1 + hstep, voffA);
            PG8_WAIT_L(8); PG8_BAR; PG8_WAIT_L(0); PG8_MMA(0, 0, At, B0); PG8_BAR; PG8_SCHED;
            PG8_LDB(B1, 0, 1); PG8_STAGE(PG8_SB(0, 0), b2, voffB);
            PG8_BAR; PG8_WAIT_L(0); PG8_MMA(0, 1, At, B1); PG8_BAR;
            PG8_LDA(At, 0, 1); PG8_STAGE(PG8_SA(0, 0), a2, voffA);
            PG8_BAR; PG8_WAIT_L(0); PG8_MMA(1, 0, At, B0); PG8_BAR; PG8_SCHED;
            PG8_STAGE(PG8_SB(0, 1), b2 + hstep, voffB);
            PG8_WAIT_V(6); PG8_BAR; PG8_MMA(1, 1, At, B1); PG8_BAR;
            PG8_LDB(B0, 1, 0); PG8_SCHED; PG8_LDA(At, 1, 0); PG8_STAGE(PG8_SA(0, 1), a2 + hstep, voffA);
            PG8_WAIT_L(8); PG8_BAR; PG8_WAIT_L(0); PG8_MMA(0, 0, At, B0); PG8_BAR; PG8_SCHED;
            PG8_LDB(B1, 1, 1); PG8_STAGE(PG8_SB(1, 0), b3, voffB);
            PG8_BAR; PG8_WAIT_L(0); PG8_MMA(0, 1, At, B1); PG8_BAR;
            PG8_LDA(At, 1, 1); PG8_STAGE(PG8_SA(1, 0), a3, voffA);
            PG8_BAR; PG8_WAIT_L(0); PG8_MMA(1, 0, At, B0); PG8_BAR; PG8_SCHED;
            PG8_STAGE(PG8_SB(1, 1), b3 + hstep, voffB);
            PG8_WAIT_V(6); PG8_BAR; PG8_MMA(1, 1, At, B1); PG8_BAR;
            }
        }
        if constexpr (ALIGN_EPI) { if (wr == 0) PG8_BAR; }
        if constexpr (!Epi::AFTER_DRAIN) { E(acc, cur, wr, wc, fr, fq); S.done(cur); }
        if (!has_next) break;
#pragma unroll
        for (int a = 0; a < 2; ++a)
#pragma unroll
            for (int b = 0; b < 2; ++b)
#pragma unroll
                for (int m = 0; m < 4; ++m)
#pragma unroll
                    for (int n = 0; n < 2; ++n) acc[a][b][m][n] = (f32x4){0.f, 0.f, 0.f, 0.f};
        cur = nxt; cA = nA; cB = nB; ++ui;
        if constexpr (ALIGN_EPI) { if (wr == 1) PG8_BAR; }
    }
    PG8_WAIT_V(0);
    if constexpr (!ALIGN_EPI) { if (wr == 0) PG8_BAR; }
    PG8_BAR;
    if constexpr (Epi::AFTER_DRAIN) { E.fused(acc, cur, wr, wc, fr, fq, lds, wid, lane); S.done(cur); }
#undef PG8_SA
#undef PG8_SB
#undef PG8_STAGE
#undef PG8_LDA
#undef PG8_LDB
#undef PG8_MMA
#undef PG8_WAIT_V
#undef PG8_WAIT_L
#undef PG8_BAR
#undef PG8_SCHED
}
}
#include <hip/hip_cooperative_groups.h>
namespace cg = cooperative_groups;
#define LAS __attribute__((address_space(3)))
typedef unsigned short bf16;
typedef float f32x4 __attribute__((ext_vector_type(4)));
typedef unsigned v4u __attribute__((ext_vector_type(4)));

constexpr int BATCH = 8, SEQ = 4096, DM = 1024, M = BATCH * SEQ, DFF = 2816, DIN = 2704, ZP = 2816, NGU = 2 * DFF, DEPTH = 2;
constexpr int NTHR = 512, NWAVES = 8;
constexpr int ZQ_FOX = 0, ZK_FOX = 256, ZV_FOX = 512, ZQ_NSA = 768, ZKC = 1024, ZVC = 1088, ZKS = 1152, ZVS = 1216, ZKW = 1280, ZVW = 1344,
              ZQ_SWA = 1408, ZK_SWA = 1664, ZV_SWA = 1792, ZQ_DIL = 1920, ZK_DIL = 2176, ZV_DIL = 2432, ZSMALL = 2688;
constexpr size_t MiB = 1u << 20;
constexpr size_t SZ_WGU = (size_t)NGU * DM * 2, SZ_WD = (size_t)DM * DFF * 2, SZ_WIN = (size_t)ZP * DM * 2, SZ_WOUT = (size_t)DM * DM * 2;
constexpr size_t OFF_WGU1 = 0, OFF_WD1 = OFF_WGU1 + SZ_WGU, OFF_WIN = OFF_WD1 + SZ_WD, OFF_WOUT = OFF_WIN + SZ_WIN, OFF_WGU2 = OFF_WOUT + SZ_WOUT, OFF_WD2 = OFF_WGU2 + SZ_WGU, LAYER_W = 43 * MiB;
static_assert(OFF_WD2 + SZ_WD <= LAYER_W, "weights per layer");
constexpr size_t WS_W = 0, WS_ZH = 86 * MiB, WS_XG = WS_ZH + 176 * MiB, WS_O = WS_XG + 64 * MiB, WS_DO = WS_O + 64 * MiB, WS_OC = WS_DO + 48 * MiB, WS_SM = WS_OC + 32 * MiB;
constexpr size_t WS_SSQ = WS_SM, WS_ZS = WS_SSQ + 2 * MiB, WS_CUM = WS_ZS + 2 * MiB, WS_KC = WS_CUM + 1 * MiB, WS_VC = WS_KC + 1 * MiB, WS_MASK = WS_VC + 1 * MiB, WS_DL = WS_MASK + 1 * MiB, WS_END = WS_DL + 2 * MiB;
static_assert((size_t)M * ZP * 2 <= 176 * MiB && WS_END <= 512 * MiB, "ws map");
constexpr size_t WS_W1T = WS_W + LAYER_W + OFF_WD2 + SZ_WD;
static_assert(OFF_WD2 + SZ_WD + 2 * MiB <= LAYER_W, "W1T fits behind layer 1's weights");
constexpr int LDS_BYTES = 147456;
#ifndef GSEL
#define GSEL 31
#endif
#ifndef REP_P4
#define REP_P4 1
#endif
#ifndef REP_P5
#define REP_P5 1
#endif
#ifndef REP_P6
#define REP_P6 1
#endif
#ifndef REP_G1
#define REP_G1 1
#endif


#ifndef REP_CPASS
#define REP_CPASS 1
#endif
#ifndef REP_CTOPK
#define REP_CTOPK 1
#endif
#ifndef REP_PRO
#define REP_PRO 1
#endif
#ifndef REP_FOX
#define REP_FOX 1
#endif
#ifndef REP_CMP
#define REP_CMP 1
#endif
#ifndef REP_DIL
#define REP_DIL 1
#endif
#ifndef FA_FOX
#define FA_FOX 1
#endif
#ifndef FA_CMP
#define FA_CMP 1
#endif
#ifndef FA_SWA
#define FA_SWA 1
#endif
#ifndef FA_DIL
#define FA_DIL 1
#endif
#ifndef FA_NSA
#define FA_NSA 1
#endif

struct Args { const float* in[18]; float* out; unsigned char* ws; };
typedef const __attribute__((address_space(4))) Args* CArgsP;

__device__ __forceinline__ unsigned f2bf(float f) { unsigned u = __builtin_bit_cast(unsigned, f); return (u + 0x7fffu + ((u >> 16) & 1u)) >> 16; }
__device__ __forceinline__ unsigned pk2(float lo, float hi) { return f2bf(lo) | (f2bf(hi) << 16); }
__device__ __forceinline__ float bflo(unsigned w) { return __uint_as_float(w << 16); }
__device__ __forceinline__ float bfhi(unsigned w) { return __uint_as_float(w & 0xffff0000u); }
__device__ __forceinline__ float wave_sum(float v) {
#pragma unroll
    for (int o = 1; o < 64; o <<= 1) v += __shfl_xor(v, o);
    return v;
}
__device__ __forceinline__ float sigmoidf_(float x) { return 1.0f / (1.0f + __expf(-x)); }

__device__ __forceinline__ void tr_item(const float* srcp, int N, int k0, bf16* dstblk, int K, LAS float* scr, int lane) {
    float v[32];
#pragma unroll
    for (int i = 0; i < 32; ++i) { const int kk = 2 * i + (lane >> 5); v[i] = srcp ? srcp[(size_t)(k0 + kk) * N] : 0.f; }
#pragma unroll
    for (int i = 0; i < 32; ++i) { const int kk = 2 * i + (lane >> 5); scr[kk * 33 + (lane & 31)] = v[i]; }
    asm volatile("s_waitcnt lgkmcnt(0)" ::: "memory");
    const int c = lane & 7;
#pragma unroll
    for (int j = 0; j < 4; ++j) { const int n = (lane >> 3) + 8 * j; const LAS float* s = scr + (8 * c) * 33 + n;
        v4u o; o.x = pk2(s[0 * 33], s[1 * 33]); o.y = pk2(s[2 * 33], s[3 * 33]); o.z = pk2(s[4 * 33], s[5 * 33]); o.w = pk2(s[6 * 33], s[7 * 33]);
        *(v4u*)(dstblk + (size_t)n * K + 8 * c) = o; }
    asm volatile("s_waitcnt lgkmcnt(0)" ::: "memory");
}
__device__ __forceinline__ int win_src_col(int r) {
    if (r < 768) return r;
    if (r < 1408) return r + 4;
    if (r < 2688) return r + 16;
    if (r < 2692) return 768 + (r - 2688);
    if (r < 2704) return 1412 + (r - 2692);
    return -1;
}
__device__ __forceinline__ void prologue(CArgsP a, LAS unsigned char* lds, int gw, int NGW, int wave, int lane) {
    LAS float* scr = (LAS float*)(lds + wave * 16384);
    constexpr int I_GU = (DM / 64) * (NGU / 32), I_D = (DFF / 64) * (DM / 32), I_IN = (DM / 64) * (ZP / 32), I_OUT = (DM / 64) * (DM / 32);
    constexpr int I_LAYER = 2 * I_GU + 2 * I_D + I_IN + I_OUT;
    for (int it = gw; it < DEPTH * I_LAYER; it += NGW) {
        const int l = it / I_LAYER; int r = it % I_LAYER;
        unsigned char* wl = a->ws + WS_W + (size_t)l * LAYER_W;
        if (r < 2 * I_GU) {
            const int f = r / I_GU; r %= I_GU; const int nblk = NGU / 32, kb = r / nblk, nb = r % nblk, d0 = nb * 32;
            const int tile = d0 / 256, within = d0 % 256; const bool up = within >= 128; const int c0 = tile * 128 + (within & 127);
            const float* W = a->in[f == 0 ? (up ? 3 : 2) : (up ? 15 : 14)] + (size_t)l * DM * DFF;
            bf16* WT = (bf16*)(wl + (f == 0 ? OFF_WGU1 : OFF_WGU2));
            tr_item(W + c0 + (lane & 31), DFF, kb * 64, WT + (size_t)d0 * DM + kb * 64, DM, scr, lane);
            continue;
        }
        r -= 2 * I_GU;
        if (r < 2 * I_D) {
            const int f = r / I_D; r %= I_D; const int nblk = DM / 32, kb = r / nblk, nb = r % nblk, d0 = nb * 32;
            const float* W = a->in[f == 0 ? 4 : 16] + (size_t)l * DFF * DM;
            bf16* WT = (bf16*)(wl + (f == 0 ? OFF_WD1 : OFF_WD2));
            tr_item(W + d0 + (lane & 31), DM, kb * 64, WT + (size_t)d0 * DFF + kb * 64, DFF, scr, lane);
            continue;
        }
        r -= 2 * I_D;
        if (r < I_IN) {
            const int nblk = ZP / 32, kb = r / nblk, nb = r % nblk, d0 = nb * 32;
            const int sc = win_src_col(d0 + (lane & 31));
            const float* W = a->in[6] + (size_t)l * DM * DIN;
            tr_item(sc >= 0 ? W + sc : nullptr, DIN, kb * 64, (bf16*)(wl + OFF_WIN) + (size_t)d0 * DM + kb * 64, DM, scr, lane);
            continue;
        }
        r -= I_IN;
        {
            const int nblk = DM / 32, kb = r / nblk, nb = r % nblk, d0 = nb * 32;
            const float* W = a->in[12] + (size_t)l * DM * DM;
            tr_item(W + d0 + (lane & 31), DM, kb * 64, (bf16*)(wl + OFF_WOUT) + (size_t)d0 * DM + kb * 64, DM, scr, lane);
        }
    }
    for (int it = gw; it < 4 * 128; it += NGW) {
        const int li = it >> 7, r = it & 127, kb = r >> 2, d0 = (r & 3) * 32;
        tr_item(a->in[9] + (size_t)li * 2048 * 128 + d0 + (lane & 31), 128, kb * 64, (bf16*)(a->ws + WS_W1T) + ((size_t)li * 128 + d0) * 2048 + kb * 64, 2048, scr, lane);
    }
    const float* x = a->in[0]; const float* g = a->in[1]; bf16* XG = (bf16*)(a->ws + WS_XG); float* SSQ = (float*)(a->ws + WS_SSQ);
    f32x4 gv[4];
#pragma unroll
    for (int j = 0; j < 4; ++j) gv[j] = *(const f32x4*)(g + 4 * lane + 256 * j);
    for (int m = gw; m < M; m += NGW) {
        const f32x4* xr = (const f32x4*)(x + (size_t)m * DM) + lane; float s = 0.f; f32x4 v[4];
#pragma unroll
        for (int j = 0; j < 4; ++j) { v[j] = xr[64 * j]; s += (v[j][0] * v[j][0] + v[j][1] * v[j][1]) + (v[j][2] * v[j][2] + v[j][3] * v[j][3]); }
        s = wave_sum(s);
        unsigned long long* o8 = (unsigned long long*)(XG + (size_t)m * DM) + lane;
#pragma unroll
        for (int j = 0; j < 4; ++j) { const f32x4 y = v[j] * gv[j]; o8[64 * j] = (unsigned long long)pk2(y[0], y[1]) | ((unsigned long long)pk2(y[2], y[3]) << 32); }
        if (lane < 16) SSQ[(size_t)m * 16 + lane] = lane == 0 ? s : 0.f;
    }
}

struct NAcc { float m, l; float o[32]; };
__device__ __forceinline__ void nacc_init(NAcc& a) { a.m = -INFINITY; a.l = 0.f;
#pragma unroll
    for (int d = 0; d < 32; ++d) a.o[d] = 0.f; }
__device__ __forceinline__ void load_q(unsigned (&q)[16], const bf16* p) {
    const v4u* p4 = (const v4u*)p;
#pragma unroll
    for (int i = 0; i < 4; ++i) { const v4u w = p4[i]; q[4 * i] = w.x; q[4 * i + 1] = w.y; q[4 * i + 2] = w.z; q[4 * i + 3] = w.w; }
}
__device__ __forceinline__ float dot32(const unsigned (&q)[16], const bf16* krow) {
    const v4u* p4 = (const v4u*)krow; float s0 = 0.f, s1 = 0.f;
#pragma unroll
    for (int i = 0; i < 4; ++i) { const v4u w = p4[i];
        s0 += bflo(q[4 * i]) * bflo(w.x); s1 += bfhi(q[4 * i]) * bfhi(w.x); s0 += bflo(q[4 * i + 1]) * bflo(w.y); s1 += bfhi(q[4 * i + 1]) * bfhi(w.y);
        s0 += bflo(q[4 * i + 2]) * bflo(w.z); s1 += bfhi(q[4 * i + 2]) * bfhi(w.z); s0 += bflo(q[4 * i + 3]) * bflo(w.w); s1 += bfhi(q[4 * i + 3]) * bfhi(w.w); }
    float s = s0 + s1; s += __shfl_xor(s, 1); return s;
}
__device__ __forceinline__ void axpy32(float (&o)[32], float p, const bf16* vrow) {
    const v4u* p4 = (const v4u*)vrow;
#pragma unroll
    for (int i = 0; i < 4; ++i) { const v4u w = p4[i];
        o[8 * i + 0] += p * bflo(w.x); o[8 * i + 1] += p * bfhi(w.x); o[8 * i + 2] += p * bflo(w.y); o[8 * i + 3] += p * bfhi(w.y);
        o[8 * i + 4] += p * bflo(w.z); o[8 * i + 5] += p * bfhi(w.z); o[8 * i + 6] += p * bflo(w.w); o[8 * i + 7] += p * bfhi(w.w); }
}
__device__ __forceinline__ void attend1(const unsigned (&q)[16], NAcc& a, const bf16* krow, const bf16* vrow, bool valid, float bias) {
    const float dq = dot32(q, krow);
    const float s = valid ? dq * 0.125f + bias : -INFINITY;
    asm volatile("" ::: "memory");
    const float mn = fmaxf(a.m, s);
    if (__any(valid)) {
        const float ms = (mn == -INFINITY) ? 0.f : mn;
        const float alpha = __expf(a.m - ms), p = __expf(s - ms);
        if (__any(mn > a.m)) {
#pragma unroll
            for (int d = 0; d < 32; ++d) a.o[d] *= alpha;
        }
        a.l = a.l * alpha + p; a.m = mn;
        axpy32(a.o, p, vrow);
    }
    asm volatile("" ::: "memory");
}
__device__ __forceinline__ void store_o_bf16(bf16* dst, const float (&o)[32], float sc) {
    v4u* p4 = (v4u*)dst;
#pragma unroll
    for (int i = 0; i < 4; ++i) { v4u w; w.x = pk2(o[8 * i] * sc, o[8 * i + 1] * sc); w.y = pk2(o[8 * i + 2] * sc, o[8 * i + 3] * sc);
        w.z = pk2(o[8 * i + 4] * sc, o[8 * i + 5] * sc); w.w = pk2(o[8 * i + 6] * sc, o[8 * i + 7] * sc); p4[i] = w; }
}
__device__ __forceinline__ float alibi_slope(int i) { return exp2f(-8.0f * (float)(i + 1) / 12.0f); }

__device__ __forceinline__ void banded(const unsigned (&q)[16], NAcc& a, const bf16* Kb, const bf16* Vb, size_t stride, int i0s, int qi, int maxd, float slope) {
    int klo = i0s - maxd; if (klo < 0) klo = 0; const int khi = i0s + 31;
#pragma unroll 1
    for (int k = klo; k <= khi; ++k) {
        const int dist = qi - k;
        attend1(q, a, Kb + (size_t)k * stride, Vb + (size_t)k * stride, dist >= 0 && dist <= maxd, -slope * (float)dist);
    }
}

__device__ __forceinline__ void p4_cumsum(CArgsP a, int l, LAS unsigned char* lds, int bh) {
    int tid = threadIdx.x; asm volatile("" : "+v"(tid)); const int b = bh >> 2, h = bh & 3;
    const float* ZS = (const float*)(a->ws + WS_ZS); float* CUM = (float*)(a->ws + WS_CUM);
    const float bf = a->in[7][l * 4 + h];
    LAS float* part = (LAS float*)lds;
    float v[8]; float s = 0.f;
#pragma unroll
    for (int i = 0; i < 8; ++i) { const int t = tid * 8 + i; const float x = ZS[(size_t)(b * SEQ + t) * 16 + h] + bf;
        const float ls = fminf(x, 0.f) - log1pf(__expf(-fabsf(x))); s += ls; v[i] = s; }
    float incl = s;
#pragma unroll
    for (int o = 1; o < 64; o <<= 1) { const float t = __shfl_up(incl, o); if ((tid & 63) >= o) incl += t; }
    if ((tid & 63) == 63) part[tid >> 6] = incl;
    __syncthreads();
    float woff = 0.f;
    for (int w = 0; w < (tid >> 6); ++w) woff += part[w];
    const float off = woff + incl - s;
#pragma unroll
    for (int i = 0; i < 8; ++i) { const float cv = v[i] + off; CUM[(size_t)bh * SEQ + tid * 8 + i] = cv;
        const float x = -8.0f * cv; const unsigned h1 = f2bf(x); const float r1 = x - __uint_as_float(h1 << 16); const unsigned h2 = f2bf(r1); const float r2 = r1 - __uint_as_float(h2 << 16); const unsigned h3 = f2bf(r2);
        *(v4u*)(a->ws + WS_W + OFF_WD2 + SZ_WD + ((size_t)bh * SEQ + tid * 8 + i) * 16) = (v4u){h1 | (h2 << 16), h3, 0u, 0u}; }
    __syncthreads();
}
__device__ __forceinline__ void p4_compress(CArgsP a, int l, LAS unsigned char* lds, int item) {
    typedef short bf16x8c __attribute__((ext_vector_type(8)));
    int tid = threadIdx.x; asm volatile("" : "+v"(tid)); const int g = item & 15, b = (item >> 4) & 7, idx = item >> 7;
    const int wave = tid >> 6, lane = tid & 63, n = lane & 15, q4 = lane >> 4;
    const bf16* Z = (const bf16*)(a->ws + WS_ZH);
    LAS bf16* xs = (LAS bf16*)lds;
    LAS float* hid = (LAS float*)(lds + 40960);
    const int n0 = g * 16, t0 = n0 * 16, col = idx == 0 ? ZKC : ZVC;
    for (int i = tid; i < 272 * 8; i += NTHR) { const int tt = i >> 3, ch = i & 7, t = t0 + tt;
        v4u v = (v4u){0u, 0u, 0u, 0u}; if (t < SEQ) v = *(const v4u*)(Z + (size_t)(b * SEQ + t) * ZP + col + ch * 8);
        *(LAS v4u*)(xs + ((tt & 15) * 17 + (tt >> 4)) * 72 + ch * 8) = v; }
    __syncthreads();
    const float* pe = a->in[8] + (size_t)(l * 2 + idx) * 32 * 64;
    const bf16* w1t = (const bf16*)(a->ws + WS_W1T) + ((size_t)(l * 2 + idx) * 128 + wave * 16 + n) * 2048;
    const float* w2 = a->in[10] + (size_t)(l * 2 + idx) * 128 * 64;
    f32x4 acc = (f32x4){0.f, 0.f, 0.f, 0.f};
#pragma unroll 4
    for (int ks = 0; ks < 64; ++ks) {
        const int ll = ks >> 1, d0 = (ks & 1) * 32 + 8 * q4;
        const v4u xa = *(const LAS v4u*)(xs + ((ll & 15) * 17 + n + (ll >> 4)) * 72 + d0);
        const f32x4 p0 = *(const f32x4*)(pe + ll * 64 + d0), p1 = *(const f32x4*)(pe + ll * 64 + d0 + 4);
        v4u am; am.x = pg8::cvt_pk_bf16(bflo(xa.x) + p0[0], bfhi(xa.x) + p0[1]); am.y = pg8::cvt_pk_bf16(bflo(xa.y) + p0[2], bfhi(xa.y) + p0[3]);
        am.z = pg8::cvt_pk_bf16(bflo(xa.z) + p1[0], bfhi(xa.z) + p1[1]); am.w = pg8::cvt_pk_bf16(bflo(xa.w) + p1[2], bfhi(xa.w) + p1[3]);
        const bf16x8c bm = *(const bf16x8c*)(w1t + ks * 32 + 8 * q4);
        acc = __builtin_amdgcn_mfma_f32_16x16x32_bf16(__builtin_bit_cast(bf16x8c, am), bm, acc, 0, 0, 0);
    }
#pragma unroll
    for (int j = 0; j < 4; ++j) { const float sv = acc[j]; hid[(4 * q4 + j) * 128 + wave * 16 + n] = sv * sigmoidf_(sv); }
    __syncthreads();
    bf16* KC = (bf16*)(a->ws + (idx == 0 ? WS_KC : WS_VC)); bf16* VCT = (bf16*)(a->ws + WS_VC + 512 * 1024);
    for (int o = tid; o < 16 * 64; o += NTHR) { const int i = o >> 6, e2 = o & 63; float sv = 0.f;
#pragma unroll 16
        for (int ee = 0; ee < 128; ++ee) sv += hid[i * 128 + ee] * w2[ee * 64 + e2];
        const int nn = n0 + i; const bf16 val = nn < 255 ? (bf16)f2bf(sv) : (bf16)0;
        const int T = nn >> 5, kk = nn & 31;
        if (idx == 0) KC[(size_t)b * 256 * 64 + ((T * 8 + (e2 >> 3)) * 32 + kk) * 8 + (e2 & 7)] = val;
        else { const int k16 = kk & 15; VCT[(size_t)b * 256 * 64 + (((((T * 2 + (e2 >> 5)) * 2 + (kk >> 4)) * 2 + ((k16 >> 2) & 1)) * 32 + (e2 & 31)) * 8) + (k16 & 3) + 4 * (k16 >> 3)] = val; } }
    __syncthreads();
}
__device__ __forceinline__ void p4_dil_item(CArgsP a, int it, int lane) {
    const int blk64 = it & 63, bh = (it >> 6) & 31, g = it >> 11; const int b = bh >> 2, h = bh & 3;
    const int dd = g == 0 ? 1 : (g == 1 ? 4 : 16); const int per = 64 / dd;
    const int r = blk64 / per, i0 = (blk64 % per) * 64; const int hoff = 32 * (lane & 1);
    const bf16* Z = (const bf16*)(a->ws + WS_ZH); const size_t rowb = (size_t)b * SEQ;
    bf16* DO = (bf16*)(a->ws + WS_DO); float* DL = (float*)(a->ws + WS_DL);
    for (int sub = 0; sub < 2; ++sub) {
        const int i0s = i0 + sub * 32, qi = i0s + (lane >> 1), t = r + dd * qi;
        unsigned q[16]; load_q(q, Z + (rowb + t) * ZP + ZQ_DIL + h * 64 + hoff);
        NAcc acc; nacc_init(acc);
        banded(q, acc, Z + (rowb + r) * ZP + ZK_DIL + h * 64 + hoff, Z + (rowb + r) * ZP + ZV_DIL + h * 64 + hoff, (size_t)dd * ZP, i0s, qi, 128, alibi_slope(8 + h) * (float)dd);
        store_o_bf16(DO + ((size_t)g * M + rowb + t) * 256 + h * 64 + hoff, acc.o, 1.0f / acc.l);
        if ((lane & 1) == 0) DL[((size_t)g * M + rowb + t) * 4 + h] = acc.m + __logf(acc.l);
    }
}
__device__ __forceinline__ void p4_swa_item(CArgsP a, int l, int it, int lane) {
    const int blk = it & 63, bh = it >> 6; const int b = bh >> 2, h = bh & 3, kvh = h >> 1; const int hoff = 32 * (lane & 1);
    const bf16* Z = (const bf16*)(a->ws + WS_ZH); const size_t rowb = (size_t)b * SEQ;
    const float sink = a->in[11][l * 4 + h];
    for (int sub = 0; sub < 2; ++sub) {
        const int i0s = blk * 64 + sub * 32, t = i0s + (lane >> 1);
        unsigned q[16]; load_q(q, Z + (rowb + t) * ZP + ZQ_SWA + h * 64 + hoff);
        NAcc acc; nacc_init(acc);
        banded(q, acc, Z + rowb * ZP + ZK_SWA + kvh * 64 + hoff, Z + rowb * ZP + ZV_SWA + kvh * 64 + hoff, (size_t)ZP, i0s, t, 127, alibi_slope(h));
        const float lse = acc.m + __logf(acc.l); const float keep = sigmoidf_(lse - sink);
        store_o_bf16((bf16*)(a->ws + WS_O) + (rowb + t) * DM + (8 + h) * 64 + hoff, acc.o, keep / acc.l);
    }
}
__device__ __forceinline__ void p5_fox_item(CArgsP a, int it, int lane) {
    const int bh = it & 31, blk = 63 - (it >> 5); const int b = bh >> 2, h = bh & 3; const int hoff = 32 * (lane & 1);
    const bf16* Z = (const bf16*)(a->ws + WS_ZH); const size_t rowb = (size_t)b * SEQ; const float* c = (const float*)(a->ws + WS_CUM) + (size_t)bh * SEQ;
    const bf16* Kb = Z + rowb * ZP + ZK_FOX + h * 64 + hoff; const bf16* Vb = Z + rowb * ZP + ZV_FOX + h * 64 + hoff;
    for (int sub = 0; sub < 2; ++sub) {
        const int t = blk * 64 + sub * 32 + (lane >> 1);
        unsigned q[16]; load_q(q, Z + (rowb + t) * ZP + ZQ_FOX + h * 64 + hoff);
        NAcc acc; nacc_init(acc); const float ct = c[t];
        const int khi = blk * 64 + sub * 32 + 31;
#pragma unroll 1
        for (int k = 0; k <= khi; ++k) attend1(q, acc, Kb + (size_t)k * ZP, Vb + (size_t)k * ZP, k <= t, ct - c[k]);
        store_o_bf16((bf16*)(a->ws + WS_O) + (rowb + t) * DM + h * 64 + hoff, acc.o, 1.0f / acc.l);
    }
}
__device__ __forceinline__ void p5_cmp_item(CArgsP a, int it, LAS float* imps  , int lane) {
    const int blk = it & 63, b = it >> 6; const size_t rowb = (size_t)b * SEQ; const int hoff = 32 * (lane & 1);
    const bf16* Z = (const bf16*)(a->ws + WS_ZH); const float* ZS = (const float*)(a->ws + WS_ZS);
    const bf16* KC = (const bf16*)(a->ws + WS_KC) + (size_t)b * 256 * 64 + hoff; const bf16* VC = (const bf16*)(a->ws + WS_VC) + (size_t)b * 256 * 64 + hoff;
    float* OC = (float*)(a->ws + WS_OC);
    for (int j = 0; j < 64; ++j) imps[lane * 65 + j] = 0.f;
    for (int sub = 0; sub < 2; ++sub) {
        const int tt = sub * 32 + (lane >> 1), t = blk * 64 + tt;
        const int tmax = blk * 64 + sub * 32 + 31; const int ncm = tmax >= 31 ? (tmax - 31) / 16 + 1 : 0;
        for (int h = 0; h < 4; ++h) {
            const float slope = alibi_slope(4 + h);
            unsigned q[16]; load_q(q, Z + (rowb + t) * ZP + ZQ_NSA + h * 64 + hoff);
            NAcc acc; nacc_init(acc);
#pragma unroll 1
            for (int n = 0; n < ncm; ++n) { const int dist = t - (16 * n + 31); attend1(q, acc, KC + n * 64, VC + n * 64, dist >= 0, -slope * (float)dist); }
            const float g0 = sigmoidf_(ZS[(rowb + t) * 16 + 4 + h * 3 + 0]);
            const float inv = 1.0f / fmaxf(acc.l, 1e-30f);
            { f32x4* o4 = (f32x4*)(OC + (rowb + t) * 256 + h * 64 + hoff); const float sc = inv * g0;
#pragma unroll
              for (int i = 0; i < 8; ++i) o4[i] = (f32x4){acc.o[4 * i] * sc, acc.o[4 * i + 1] * sc, acc.o[4 * i + 2] * sc, acc.o[4 * i + 3] * sc}; }
            const float ms = (acc.m == -INFINITY) ? 0.f : acc.m;
            float cur = 0.f; const bool wr = (lane & 1) == 0;
#pragma unroll 1
            for (int n = 0; n < ncm; ++n) {
                const int dist = t - (16 * n + 31);
                const float dq = dot32(q, KC + n * 64);
                const float s = dist >= 0 ? dq * 0.125f - slope * (float)dist : -INFINITY;
                const float p = __expf(s - ms) * inv;
                cur += p;
                if ((n & 3) == 3) { if (wr) imps[tt * 65 + (n >> 2)] += cur; cur = p; }
            }
            if (ncm > 0 && (ncm >> 2) < 64 && wr) imps[tt * 65 + (ncm >> 2)] += cur;
        }
    }
    unsigned long long mymask = 0ull;
    for (int tt = 0; tt < 64; ++tt) {
        const int curb = blk;
        const float imp = imps[tt * 65 + lane];
        const bool causal = lane <= curb; const bool forced = (lane == 0) || (lane == curb) || (lane == curb - 1);
        const float score = causal ? (forced ? INFINITY : imp) : -INFINITY;
        int rank = 0;
        for (int jj = 0; jj < 64; ++jj) { const float o = __shfl(score, jj); rank += (o > score || (o == score && jj < lane)) ? 1 : 0; }
        const unsigned long long mk = __ballot(rank < 16 && causal);
        if (lane == tt) mymask = mk;
    }
    ((unsigned long long*)(a->ws + WS_MASK))[rowb + blk * 64 + lane] = mymask;
}
__device__ __forceinline__ void p5_dilcomb_item(CArgsP a, int it, int lane_in) {
    int lane = lane_in; asm volatile("" : "+v"(lane));
    const int blk = it & 63, bh = it >> 6; const int b = bh >> 2, h = bh & 3; const size_t row = (size_t)b * SEQ + blk * 64 + lane;
    const bf16* DO = (const bf16*)(a->ws + WS_DO); const float* DL = (const float*)(a->ws + WS_DL);
    const float l0 = DL[row * 4 + h], l1 = DL[((size_t)M + row) * 4 + h], l2 = DL[((size_t)2 * M + row) * 4 + h];
    const float mx = fmaxf(l0, fmaxf(l1, l2)); float w0 = __expf(l0 - mx), w1 = __expf(l1 - mx), w2 = __expf(l2 - mx); const float inv = 1.0f / (w0 + w1 + w2); w0 *= inv; w1 *= inv; w2 *= inv;
    const v4u* p0 = (const v4u*)(DO + row * 256 + h * 64); const v4u* p1 = (const v4u*)(DO + ((size_t)M + row) * 256 + h * 64); const v4u* p2 = (const v4u*)(DO + ((size_t)2 * M + row) * 256 + h * 64);
    v4u* o4 = (v4u*)((bf16*)(a->ws + WS_O) + row * DM + (12 + h) * 64);
#pragma unroll 2
    for (int i = 0; i < 8; ++i) { const v4u x = p0[i], y = p1[i], z = p2[i]; v4u w;
        w.x = pk2(w0 * bflo(x.x) + w1 * bflo(y.x) + w2 * bflo(z.x), w0 * bfhi(x.x) + w1 * bfhi(y.x) + w2 * bfhi(z.x));
        w.y = pk2(w0 * bflo(x.y) + w1 * bflo(y.y) + w2 * bflo(z.y), w0 * bfhi(x.y) + w1 * bfhi(y.y) + w2 * bfhi(z.y));
        w.z = pk2(w0 * bflo(x.z) + w1 * bflo(y.z) + w2 * bflo(z.z), w0 * bfhi(x.z) + w1 * bfhi(y.z) + w2 * bfhi(z.z));
        w.w = pk2(w0 * bflo(x.w) + w1 * bflo(y.w) + w2 * bflo(z.w), w0 * bfhi(x.w) + w1 * bfhi(y.w) + w2 * bfhi(z.w));
        o4[i] = w; }
}
__device__ __forceinline__ void p6_nsa_item(CArgsP a, int it, int lane) {
    const int bh = it & 31, blk = 63 - (it >> 5); const int b = bh >> 2, h = bh & 3; const size_t rowb = (size_t)b * SEQ; const int hoff = 32 * (lane & 1);
    const bf16* Z = (const bf16*)(a->ws + WS_ZH); const float* ZS = (const float*)(a->ws + WS_ZS);
    const float slope = alibi_slope(4 + h);
    for (int sub = 0; sub < 2; ++sub) {
        const int i0s = blk * 64 + sub * 32, t = i0s + (lane >> 1);
        unsigned q[16]; load_q(q, Z + (rowb + t) * ZP + ZQ_NSA + h * 64 + hoff);
        const unsigned long long mask = ((const unsigned long long*)(a->ws + WS_MASK))[rowb + t];
        float* OC = (float*)(a->ws + WS_OC) + (rowb + t) * 256 + h * 64 + hoff;
        const float g1 = sigmoidf_(ZS[(rowb + t) * 16 + 4 + h * 3 + 1]), g2 = sigmoidf_(ZS[(rowb + t) * 16 + 4 + h * 3 + 2]);
        {
            NAcc acc; nacc_init(acc);
            const bf16* Kb = Z + rowb * ZP + ZKS + hoff; const bf16* Vb = Z + rowb * ZP + ZVS + hoff;
            for (int j = 0; j <= blk; ++j) {
                const bool sel = (mask >> j) & 1ull;
                if (!__any(sel)) continue;
#pragma unroll 1
                for (int k = j * 64; k < j * 64 + 64; ++k) attend1(q, acc, Kb + (size_t)k * ZP, Vb + (size_t)k * ZP, sel && k <= t, -slope * (float)(t - k));
            }
            const float sc = g1 / fmaxf(acc.l, 1e-30f);
            f32x4* o4 = (f32x4*)OC;
#pragma unroll
            for (int i = 0; i < 8; ++i) { f32x4 v = o4[i]; v[0] += acc.o[4 * i] * sc; v[1] += acc.o[4 * i + 1] * sc; v[2] += acc.o[4 * i + 2] * sc; v[3] += acc.o[4 * i + 3] * sc; o4[i] = v; }
        }
        asm volatile("" ::: "memory");
        {
            NAcc acc; nacc_init(acc);
            banded(q, acc, Z + rowb * ZP + ZKW + hoff, Z + rowb * ZP + ZVW + hoff, (size_t)ZP, i0s, t, 511, slope);
            const float sc = g2 / acc.l;
            const f32x4* o4 = (const f32x4*)OC; v4u* d4 = (v4u*)((bf16*)(a->ws + WS_O) + (rowb + t) * DM + (4 + h) * 64 + hoff);
#pragma unroll
            for (int i = 0; i < 4; ++i) { const f32x4 x = o4[2 * i], y = o4[2 * i + 1]; v4u w;
                w.x = pk2(x[0] + acc.o[8 * i] * sc, x[1] + acc.o[8 * i + 1] * sc); w.y = pk2(x[2] + acc.o[8 * i + 2] * sc, x[3] + acc.o[8 * i + 3] * sc);
                w.z = pk2(y[0] + acc.o[8 * i + 4] * sc, y[1] + acc.o[8 * i + 5] * sc); w.w = pk2(y[2] + acc.o[8 * i + 6] * sc, y[3] + acc.o[8 * i + 7] * sc); d4[i] = w; }
        }
    }
}

typedef short bf16x8 __attribute__((ext_vector_type(8)));
typedef float f32x16 __attribute__((ext_vector_type(16)));
typedef unsigned u32x2_t __attribute__((ext_vector_type(2)));
constexpr float LOG2E = 1.4426950408889634f, C2S = 0.125f * 1.4426950408889634f, LN2F = 0.6931471805599453f;
constexpr size_t WS_VT_SWA = 504 * MiB;
constexpr size_t WS_KF_FOX = WS_OC, WS_VF_FOX = WS_OC + 16 * MiB;
constexpr size_t WS_KF_NS = 480 * MiB, WS_VF_NS = 484 * MiB, WS_KF_NW = 488 * MiB, WS_VF_NW = 492 * MiB;
constexpr size_t WS_OCB = WS_XG + 48 * MiB;
constexpr size_t WS_VT_DIL = WS_XG;
constexpr size_t WS_VCT = WS_VC + 512 * 1024;
constexpr size_t WS_CKA = WS_W + OFF_WD2 + SZ_WD;
static_assert(OFF_WD2 + SZ_WD + 2 * MiB <= LAYER_W, "CKA fits behind layer 0's weights");
static_assert(WS_END <= 480 * MiB, "small region vs V^T buffers");

__device__ __forceinline__ int crow(int r, int hi) { return (r & 3) + 8 * (r >> 2) + 4 * hi; }
struct FA { f32x16 o0, o1; float m, l; };
__device__ __forceinline__ void fa_init(FA& s) { s.m = -INFINITY; s.l = 0.f;
#pragma unroll
    for (int r = 0; r < 16; ++r) { s.o0[r] = 0.f; s.o1[r] = 0.f; } }
__device__ __forceinline__ void load_frag4(bf16x8 (&f)[4], const bf16* row, int hi) {
#pragma unroll
    for (int d0 = 0; d0 < 4; ++d0) f[d0] = *(const bf16x8*)(row + d0 * 16 + hi * 8);
}
__device__ __forceinline__ void load_vfrag(bf16x8 (&vf)[2][2], const bf16* vt, size_t vstride) {
#pragma unroll
    for (int dh = 0; dh < 2; ++dh)
#pragma unroll
        for (int i = 0; i < 2; ++i) { const bf16* p = vt + (size_t)dh * 32 * vstride + 16 * i;
            const u32x2_t a = *(const u32x2_t*)p, b = *(const u32x2_t*)(p + 8); vf[dh][i] = __builtin_bit_cast(bf16x8, (v4u){a.x, a.y, b.x, b.y}); }
}
__device__ __forceinline__ f32x16 qk_tile(const bf16x8 (&kf)[4], const bf16x8 (&qf)[4]) {
    f32x16 s;
#pragma unroll
    for (int r = 0; r < 16; ++r) s[r] = 0.f;
#pragma unroll
    for (int d0 = 0; d0 < 4; ++d0) s = __builtin_amdgcn_mfma_f32_32x32x16_bf16(kf[d0], qf[d0], s, 0, 0, 0);
    return s;
}
__device__ __forceinline__ void fa_softmax_pv(FA& st, f32x16& s, const bf16x8 (&vf)[2][2]) {
    float tmax = s[0];
#pragma unroll
    for (int r = 1; r < 16; ++r) tmax = fmaxf(tmax, s[r]);
    tmax = fmaxf(tmax, __shfl_xor(tmax, 32));
    const float mn = fmaxf(st.m, tmax);
    if (__any(mn > st.m)) {
        const float ms0 = (mn == -INFINITY) ? 0.f : mn;
        const float alpha = __builtin_amdgcn_exp2f(st.m - ms0);
        st.l *= alpha;
#pragma unroll
        for (int r = 0; r < 16; ++r) { st.o0[r] *= alpha; st.o1[r] *= alpha; }
        st.m = mn;
    }
    const float ms = (st.m == -INFINITY) ? 0.f : st.m;
    float ps = 0.f;
#pragma unroll
    for (int r = 0; r < 16; ++r) { s[r] = __builtin_amdgcn_exp2f(s[r] - ms); ps += s[r]; }
    st.l += ps;
    unsigned pk[8];
#pragma unroll
    for (int j = 0; j < 8; ++j) pk[j] = pg8::cvt_pk_bf16(s[2 * j], s[2 * j + 1]);
#pragma unroll
    for (int i = 0; i < 2; ++i) { const bf16x8 pb = __builtin_bit_cast(bf16x8, (v4u){pk[4 * i], pk[4 * i + 1], pk[4 * i + 2], pk[4 * i + 3]});
        st.o0 = __builtin_amdgcn_mfma_f32_32x32x16_bf16(vf[0][i], pb, st.o0, 0, 0, 0);
        st.o1 = __builtin_amdgcn_mfma_f32_32x32x16_bf16(vf[1][i], pb, st.o1, 0, 0, 0); }
}
struct FTile { bf16x8 k[4]; bf16x8 ka; };
struct VTile { bf16x8 v[2][2]; };
struct RangeIt { int tlo, thi, tfull;
    __device__ __forceinline__ int first() const { return tlo <= thi ? tlo : -1; }
    __device__ __forceinline__ int next(int t) const { return t < thi ? t + 1 : -1; }
    __device__ __forceinline__ bool masked(int t) const { return t < tfull || t == thi; }
    __device__ __forceinline__ bool block_ok(int t) const { return t >= tfull && t + 5 < thi; }
    __device__ __forceinline__ int clampt(int t) const { return t < thi ? t : thi; } };
template <bool CK, bool FRAG, bool VFRAG, class F, class It> __device__ __forceinline__ void fa_stream(FA& st, const bf16x8 (&qf)[4], const bf16* Kb, size_t kstride, const bf16* vtl, size_t vstride, const bf16* cka, const It& it, int r32, int hi, F f) {
    int ta = it.first(); if (ta < 0) return;
    int tb = it.next(ta), tc = tb >= 0 ? it.next(tb) : -1;
    FTile T0, T1, T2; VTile V0, V1;
    bf16x8 qa;
#pragma unroll
    for (int j = 0; j < 8; ++j) qa[j] = (short)((hi == 0 && j < 3) ? 0x3F80 : 0);
#define FA_LOAD(T, t_) do { if (FRAG) { _Pragma("unroll") for (int d0_ = 0; d0_ < 4; ++d0_) T.k[d0_] = *(const bf16x8*)(Kb + (size_t)(t_) * 2048 + ((d0_ * 2 + hi) * 32 + r32) * 8); } \
        else load_frag4(T.k, Kb + (size_t)((t_) * 32 + r32) * kstride, hi); \
        if (CK) { T.ka = *(const bf16x8*)(cka + (size_t)((t_) * 32 + r32) * 8); } } while (0)
#define FA_LOADV(V, t_) do { if (VFRAG) { _Pragma("unroll") for (int u_ = 0; u_ < 4; ++u_) V.v[u_ >> 1][u_ & 1] = *(const bf16x8*)(vtl + (size_t)(t_) * 2048 + ((u_ * 2 + hi) * 32 + r32) * 8); } \
        else load_vfrag(V.v, vtl + (t_) * 32, vstride); } while (0)
#define FA_STEP(T, V, t_) do { f32x16 s_ = qk_tile(T.k, qf); const int k0_ = (t_) * 32; \
        if (CK) { bf16x8 ka_ = T.ka; if (hi) { _Pragma("unroll") for (int j = 0; j < 8; ++j) ka_[j] = 0; } s_ = __builtin_amdgcn_mfma_f32_32x32x16_bf16(ka_, qa, s_, 0, 0, 0); } \
        f.begin_tile(k0_); if (f.tile_masked(it.masked(t_))) { _Pragma("unroll") for (int r = 0; r < 16; ++r) { const int key_ = k0_ + crow(r, hi); s_[r] = f.valid(key_) ? f.plain(key_, s_[r]) : -INFINITY; } } \
        else { _Pragma("unroll") for (int r = 0; r < 16; ++r) s_[r] = f.plain(k0_ + crow(r, hi), s_[r]); } \
        fa_softmax_pv(st, s_, V.v); } while (0)
    const int tsafe = ta;
#define CL(t_) ((t_) >= 0 ? (t_) : tsafe)
    FA_LOADV(V0, ta); FA_LOAD(T0, ta); FA_LOAD(T1, CL(tb));
#define FA_STEP_U(T, V, t_) do { f32x16 s_ = qk_tile(T.k, qf); const int k0_ = (t_) * 32; \
        if (CK) { bf16x8 ka_ = T.ka; if (hi) { _Pragma("unroll") for (int j = 0; j < 8; ++j) ka_[j] = 0; } s_ = __builtin_amdgcn_mfma_f32_32x32x16_bf16(ka_, qa, s_, 0, 0, 0); } \
        f.begin_tile(k0_); _Pragma("unroll") for (int r = 0; r < 16; ++r) s_[r] = f.plain(k0_ + crow(r, hi), s_[r]); \
        fa_softmax_pv(st, s_, V.v); } while (0)
#pragma unroll 1
    while (it.block_ok(ta)) {
        FA_LOADV(V1, ta + 1); FA_LOAD(T2, ta + 2); FA_STEP_U(T0, V0, ta);
        FA_LOADV(V0, ta + 2); FA_LOAD(T0, ta + 3); FA_STEP_U(T1, V1, ta + 1);
        FA_LOADV(V1, ta + 3); FA_LOAD(T1, ta + 4); FA_STEP_U(T2, V0, ta + 2);
        FA_LOADV(V0, ta + 4); FA_LOAD(T2, ta + 5); FA_STEP_U(T0, V1, ta + 3);
        FA_LOADV(V1, ta + 5); FA_LOAD(T0, it.clampt(ta + 6)); FA_STEP_U(T1, V0, ta + 4);
        FA_LOADV(V0, it.clampt(ta + 6)); FA_LOAD(T1, it.clampt(ta + 7)); FA_STEP_U(T2, V1, ta + 5);
        ta += 6;
    }
    tb = it.next(ta); tc = tb >= 0 ? it.next(tb) : -1;
#undef FA_STEP_U
#pragma unroll 1
    for (;;) {
        FA_LOADV(V1, CL(tb)); FA_LOAD(T2, CL(tc));
        FA_STEP(T0, V0, ta); if (tb < 0) break; ta = tc >= 0 ? it.next(tc) : -1;
        FA_LOADV(V0, CL(tc)); FA_LOAD(T0, CL(ta));
        FA_STEP(T1, V1, tb); if (tc < 0) break; tb = ta >= 0 ? it.next(ta) : -1;
        FA_LOADV(V1, CL(ta)); FA_LOAD(T1, CL(tb));
        FA_STEP(T2, V0, tc); if (ta < 0) break; tc = tb >= 0 ? it.next(tb) : -1;
        FA_LOADV(V0, CL(tb)); FA_LOAD(T2, CL(tc));
        FA_STEP(T0, V1, ta); if (tb < 0) break; ta = tc >= 0 ? it.next(tc) : -1;
        FA_LOADV(V1, CL(tc)); FA_LOAD(T0, CL(ta));
        FA_STEP(T1, V0, tb); if (tc < 0) break; tb = ta >= 0 ? it.next(ta) : -1;
        FA_LOADV(V0, CL(ta)); FA_LOAD(T1, CL(tb));
        FA_STEP(T2, V1, tc); if (ta < 0) break; tc = tb >= 0 ? it.next(tb) : -1;
    }
#undef CL
#undef FA_LOADV
#undef FA_LOAD
#undef FA_STEP
}
__device__ __forceinline__ void store_ot_bf16(bf16* orow, const f32x16& o0, const f32x16& o1, float sc, int hi) {
#pragma unroll
    for (int a4 = 0; a4 < 4; ++a4) {
        u32x2_t w0, w1;
        w0.x = pg8::cvt_pk_bf16(o0[4 * a4] * sc, o0[4 * a4 + 1] * sc); w0.y = pg8::cvt_pk_bf16(o0[4 * a4 + 2] * sc, o0[4 * a4 + 3] * sc);
        w1.x = pg8::cvt_pk_bf16(o1[4 * a4] * sc, o1[4 * a4 + 1] * sc); w1.y = pg8::cvt_pk_bf16(o1[4 * a4 + 2] * sc, o1[4 * a4 + 3] * sc);
        *(u32x2_t*)(orow + 8 * a4 + 4 * hi) = w0; *(u32x2_t*)(orow + 32 + 8 * a4 + 4 * hi) = w1;
    }
}
struct BandF { int qi, maxd; float slope2;
    __device__ __forceinline__ void begin_tile(int) {}
    __device__ __forceinline__ bool tile_masked(bool m) const { return m; }
    __device__ __forceinline__ float plain(int key, float raw) const { return raw * C2S - slope2 * (float)(qi - key); }
    __device__ __forceinline__ bool valid(int key) const { const int dist = qi - key; return dist >= 0 && dist <= maxd; } };
__device__ __forceinline__ int band_tfull(int i0, int maxd) { const int x = i0 + 31 - maxd; return x <= 0 ? 0 : (x + 31) >> 5; }

__device__ __forceinline__ void p4_vt_item(CArgsP a, int it, LAS unsigned short* scr  , int lane_in) {
    int lane = lane_in; asm volatile("" : "+v"(lane));
    const int ct = 6 + it % 6, tt = it / 6; const int b = tt >> 6, t0 = (tt & 63) * 64;
    const int scol = ct < 4 ? ZV_FOX + ct * 64 : (ct == 4 ? ZVS : (ct == 5 ? ZVW : (ct < 8 ? ZV_SWA + (ct - 6) * 64 : ZV_DIL + (ct - 8) * 64)));
    const bf16* Z = (const bf16*)(a->ws + WS_ZH);
    { const v4u* src = (const v4u*)(Z + ((size_t)b * SEQ + t0 + lane) * ZP + scol);
#pragma unroll
      for (int i = 0; i < 8; ++i) { const v4u w = src[i]; LAS unsigned* d = (LAS unsigned*)(scr + lane * 66 + 8 * i); d[0] = w.x; d[1] = w.y; d[2] = w.z; d[3] = w.w; } }
    asm volatile("s_waitcnt lgkmcnt(0)" ::: "memory");
    unsigned v[64];
#pragma unroll
    for (int t = 0; t < 64; ++t) v[t] = scr[t * 66 + lane];
    asm volatile("s_waitcnt lgkmcnt(0)" ::: "memory");
    if (ct < 8) {
        bf16* dst = (bf16*)(a->ws + WS_VT_SWA);
        const int ncol = 128; const int c = (ct - 6) * 64 + lane;
        v4u* o = (v4u*)(dst + ((size_t)b * ncol + c) * SEQ + t0);
#pragma unroll
        for (int i = 0; i < 8; ++i) o[i] = (v4u){v[8 * i] | (v[8 * i + 1] << 16), v[8 * i + 2] | (v[8 * i + 3] << 16), v[8 * i + 4] | (v[8 * i + 5] << 16), v[8 * i + 6] | (v[8 * i + 7] << 16)};
    } else {
        const int c = (ct - 8) * 64 + lane; bf16* base = (bf16*)(a->ws + WS_VT_DIL) + ((size_t)b * 256 + c) * SEQ;
        { v4u* o = (v4u*)(base + t0);
#pragma unroll
          for (int i = 0; i < 8; ++i) o[i] = (v4u){v[8 * i] | (v[8 * i + 1] << 16), v[8 * i + 2] | (v[8 * i + 3] << 16), v[8 * i + 4] | (v[8 * i + 5] << 16), v[8 * i + 6] | (v[8 * i + 7] << 16)}; }
        { bf16* b1 = base + (size_t)BATCH * 256 * SEQ;
#pragma unroll
          for (int r = 0; r < 4; ++r) { v4u* o = (v4u*)(b1 + r * (SEQ / 4) + t0 / 4);
#pragma unroll
              for (int i = 0; i < 2; ++i) o[i] = (v4u){v[4 * (8 * i) + r] | (v[4 * (8 * i + 1) + r] << 16), v[4 * (8 * i + 2) + r] | (v[4 * (8 * i + 3) + r] << 16),
                                                       v[4 * (8 * i + 4) + r] | (v[4 * (8 * i + 5) + r] << 16), v[4 * (8 * i + 6) + r] | (v[4 * (8 * i + 7) + r] << 16)}; } }
        { bf16* b2 = base + (size_t)2 * BATCH * 256 * SEQ;
#pragma unroll
          for (int r = 0; r < 16; ++r) { u32x2_t w; w.x = v[r] | (v[16 + r] << 16); w.y = v[32 + r] | (v[48 + r] << 16); *(u32x2_t*)(b2 + r * (SEQ / 16) + t0 / 16) = w; } }
    }
}

__device__ __forceinline__ void p4_kfrag_item(CArgsP a, int it, int lane_in) {
    int lane = lane_in; asm volatile("" : "+v"(lane));
    const int slot = 4 + (it & 1), tt = it >> 1; const int b = tt >> 7, T = tt & 127, r32 = lane & 31, hi = lane >> 5;
    const int col = slot == 4 ? ZKS : ZKW;
    const bf16* src = (const bf16*)(a->ws + WS_ZH) + ((size_t)b * SEQ + T * 32 + r32) * ZP + col + hi * 8;
    bf16* dst = (bf16*)(a->ws + (slot < 4 ? WS_KF_FOX : (slot == 4 ? WS_KF_NS : WS_KF_NW))) + ((size_t)(slot < 4 ? b * 4 + slot : b) * 128 + T) * 2048 + (hi * 32 + r32) * 8;
#pragma unroll
    for (int d0 = 0; d0 < 4; ++d0) *(v4u*)(dst + d0 * 512) = *(const v4u*)(src + d0 * 16);
}
__device__ __forceinline__ void p4_vfrag_item(CArgsP a, int it, LAS unsigned short* scr  , int lane_in) {
    int lane = lane_in; asm volatile("" : "+v"(lane));
    const int slot = it % 6, tt = it / 6; const int b = tt >> 7, T = tt & 127, r32 = lane & 31, hi = lane >> 5;
    const int col = slot < 4 ? ZV_FOX + slot * 64 : (slot == 4 ? ZVS : ZVW);
    { const v4u* src = (const v4u*)((const bf16*)(a->ws + WS_ZH) + ((size_t)b * SEQ + T * 32 + r32) * ZP + col + hi * 32);
#pragma unroll
      for (int i = 0; i < 4; ++i) { const v4u w = src[i]; LAS unsigned* d = (LAS unsigned*)(scr + r32 * 66 + hi * 32 + 8 * i); d[0] = w.x; d[1] = w.y; d[2] = w.z; d[3] = w.w; } }
    asm volatile("s_waitcnt lgkmcnt(0)" ::: "memory");
    bf16* dst = (bf16*)(a->ws + (slot < 4 ? WS_VF_FOX : (slot == 4 ? WS_VF_NS : WS_VF_NW))) + ((size_t)(slot < 4 ? b * 4 + slot : b) * 128 + T) * 2048 + (hi * 32 + r32) * 8;
#pragma unroll
    for (int dh = 0; dh < 2; ++dh)
#pragma unroll
        for (int i = 0; i < 2; ++i) { unsigned v[8];
#pragma unroll
            for (int j = 0; j < 8; ++j) v[j] = scr[(16 * i + 4 * hi + (j & 3) + 8 * (j >> 2)) * 66 + dh * 32 + r32];
            *(v4u*)(dst + (dh * 2 + i) * 512) = (v4u){v[0] | (v[1] << 16), v[2] | (v[3] << 16), v[4] | (v[5] << 16), v[6] | (v[7] << 16)}; }
    asm volatile("s_waitcnt lgkmcnt(0)" ::: "memory");
}

__device__ __forceinline__ void p4_vfrag2_item(CArgsP a, int it, LAS unsigned short* scr  , int lane_in) {
    int lane = lane_in; asm volatile("" : "+v"(lane));
    const int T = it & 127, b = (it >> 7) & 7, slot = it >> 10, r32 = lane & 31, hi = lane >> 5;
    int col, dd, sl; bf16* dst;
    if (slot < 2) { col = ZV_SWA + slot * 64; dd = 1; sl = SEQ; dst = (bf16*)(a->ws + WS_VT_SWA) + ((size_t)(b * 2 + slot) * 128 + T) * 2048; }
    else { const int g = (slot - 2) >> 2, h = (slot - 2) & 3; col = ZV_DIL + h * 64; dd = g == 0 ? 1 : (g == 1 ? 4 : 16); sl = SEQ / dd; dst = (bf16*)(a->ws + WS_VT_DIL) + ((size_t)(g * 32 + b * 4 + h) * 128 + T) * 2048; }
    const int p = T * 32 + r32, r = p / sl, j = p % sl, tok = r + dd * j;
    { const v4u* src = (const v4u*)((const bf16*)(a->ws + WS_ZH) + ((size_t)b * SEQ + tok) * ZP + col + hi * 32);
#pragma unroll
      for (int i = 0; i < 4; ++i) { const v4u w = src[i]; LAS unsigned* d = (LAS unsigned*)(scr + r32 * 66 + hi * 32 + 8 * i); d[0] = w.x; d[1] = w.y; d[2] = w.z; d[3] = w.w; } }
    asm volatile("s_waitcnt lgkmcnt(0)" ::: "memory");
    dst += (hi * 32 + r32) * 8;
#pragma unroll
    for (int dh = 0; dh < 2; ++dh)
#pragma unroll
        for (int i = 0; i < 2; ++i) { unsigned v[8];
#pragma unroll
            for (int jj = 0; jj < 8; ++jj) v[jj] = scr[(16 * i + 4 * hi + (jj & 3) + 8 * (jj >> 2)) * 66 + dh * 32 + r32];
            *(v4u*)(dst + (dh * 2 + i) * 512) = (v4u){v[0] | (v[1] << 16), v[2] | (v[3] << 16), v[4] | (v[5] << 16), v[6] | (v[7] << 16)}; }
    asm volatile("s_waitcnt lgkmcnt(0)" ::: "memory");
}

struct FoxF { int tq; float cq2;
    __device__ __forceinline__ void begin_tile(int) {}
    __device__ __forceinline__ bool tile_masked(bool m) const { return m; }
    __device__ __forceinline__ float plain(int, float raw) const { return raw * C2S + cq2; }
    __device__ __forceinline__ bool valid(int key) const { return key <= tq; } };
__device__ __forceinline__ void fa_fox_item(CArgsP a, int bh, int qt, int lane_in) {
    int lane = lane_in; asm volatile("" : "+v"(lane));
    const int b = bh >> 2, h = bh & 3, r32 = lane & 31, hi = lane >> 5; const int tq = qt * 32 + r32; const size_t rowb = (size_t)b * SEQ;
    const bf16* Z = (const bf16*)(a->ws + WS_ZH); const float* c = (const float*)(a->ws + WS_CUM) + (size_t)bh * SEQ;
    bf16x8 qf[4]; load_frag4(qf, Z + (rowb + tq) * ZP + ZQ_FOX + h * 64, hi);
    FA st; fa_init(st);
    const bf16* vtl = (const bf16*)(a->ws + WS_VF_FOX) + (size_t)bh * 128 * 2048;
    fa_stream<true, true, true>(st, qf, (const bf16*)(a->ws + WS_KF_FOX) + (size_t)bh * 128 * 2048, (size_t)ZP, vtl, (size_t)SEQ, (const bf16*)(a->ws + WS_CKA) + (size_t)bh * SEQ * 8, RangeIt{0, qt, 0}, r32, hi, FoxF{tq, c[tq] * LOG2E});
    const float l = st.l + __shfl_xor(st.l, 32);
    store_ot_bf16((bf16*)(a->ws + WS_O) + (rowb + tq) * DM + h * 64, st.o0, st.o1, 1.0f / l, hi);
}
__device__ __forceinline__ void fa_swa_item(CArgsP a, int l_, int it, int lane_in) {
    int lane = lane_in; asm volatile("" : "+v"(lane));
    const int qt = it & 127, bh = it >> 7; const int b = bh >> 2, h = bh & 3, kvh = h >> 1, r32 = lane & 31, hi = lane >> 5; const int tq = qt * 32 + r32; const size_t rowb = (size_t)b * SEQ;
    const bf16* Z = (const bf16*)(a->ws + WS_ZH);
    bf16x8 qf[4]; load_frag4(qf, Z + (rowb + tq) * ZP + ZQ_SWA + h * 64, hi);
    FA st; fa_init(st);
    const bf16* vtl = (const bf16*)(a->ws + WS_VT_SWA) + (size_t)(b * 2 + kvh) * 128 * 2048;
    int tlo = (qt * 32 - 127); tlo = tlo < 0 ? 0 : tlo >> 5;
    fa_stream<false, false, true>(st, qf, Z + rowb * ZP + ZK_SWA + kvh * 64, (size_t)ZP, vtl, (size_t)SEQ, nullptr, RangeIt{tlo, qt, band_tfull(qt * 32, 127)}, r32, hi, BandF{tq, 127, alibi_slope(h) * LOG2E});
    const float l = st.l + __shfl_xor(st.l, 32);
    const float lse = (st.m + __log2f(l)) * LN2F; const float keep = sigmoidf_(lse - a->in[11][l_ * 4 + h]);
    store_ot_bf16((bf16*)(a->ws + WS_O) + (rowb + tq) * DM + (8 + h) * 64, st.o0, st.o1, keep / l, hi);
}
__device__ __forceinline__ void fa_dil_item(CArgsP a, int it, int lane_in) {
    int lane = lane_in; asm volatile("" : "+v"(lane));
    const int pt = it & 127, bh = (it >> 7) & 31, g = it >> 12; const int b = bh >> 2, h = bh & 3, r32 = lane & 31, hi = lane >> 5; const size_t rowb = (size_t)b * SEQ;
    const int dd = g == 0 ? 1 : (g == 1 ? 4 : 16); const int sl = SEQ / dd;
    const int p0 = pt * 32; const int r = p0 / sl, j0 = p0 % sl; const int qt = j0 >> 5; const int qi = j0 + r32; const int t = r + dd * qi;
    const bf16* Z = (const bf16*)(a->ws + WS_ZH);
    bf16x8 qf[4]; load_frag4(qf, Z + (rowb + t) * ZP + ZQ_DIL + h * 64, hi);
    FA st; fa_init(st);
    const bf16* vtl = (const bf16*)(a->ws + WS_VT_DIL) + ((size_t)(g * 32 + bh) * 128 + (r * sl) / 32) * 2048;
    int tlo = j0 - 128; tlo = tlo < 0 ? 0 : tlo >> 5;
    fa_stream<false, false, true>(st, qf, Z + (rowb + r) * ZP + ZK_DIL + h * 64, (size_t)dd * ZP, vtl, (size_t)SEQ, nullptr, RangeIt{tlo, qt, band_tfull(j0, 128)}, r32, hi, BandF{qi, 128, alibi_slope(8 + h) * (float)dd * LOG2E});
    const float l = st.l + __shfl_xor(st.l, 32);
    store_ot_bf16((bf16*)(a->ws + WS_DO) + ((size_t)g * M + rowb + t) * 256 + h * 64, st.o0, st.o1, 1.0f / l, hi);
    if (hi == 0) ((float*)(a->ws + WS_DL))[((size_t)g * M + rowb + t) * 4 + h] = (st.m + __log2f(l)) * LN2F;
}
__device__ __forceinline__ void fa_cmp_passes(CArgsP a, int b, int qt, int h0, int h1, LAS float* imps  , int lane_in) {
    int lane = lane_in; asm volatile("" : "+v"(lane));
    for (int j = lane; j < 32 * 65; j += 64) imps[j] = 0.f;
    const int r32 = lane & 31, hi = lane >> 5; const int tq = qt * 32 + r32; const size_t rowb = (size_t)b * SEQ;
    const bf16* Z = (const bf16*)(a->ws + WS_ZH); const float* ZS = (const float*)(a->ws + WS_ZS);
    const bf16* KC = (const bf16*)(a->ws + WS_KC) + (size_t)b * 256 * 64; const bf16* VCF = (const bf16*)(a->ws + WS_VCT) + (size_t)b * 256 * 64;
    const int tmax = qt * 32 + 31; const int ncm = tmax >= 31 ? (tmax - 31) / 16 + 1 : 0; const int nt = (ncm + 31) >> 5;
    for (int h = h0; h < h1; ++h) {
        const float slope2 = alibi_slope(4 + h) * LOG2E;
        bf16x8 qf[4]; load_frag4(qf, Z + (rowb + tq) * ZP + ZQ_NSA + h * 64, hi);
        float m = -INFINITY, l = 0.f;
        bf16x8 kA[4], kB[4]; bf16x8 vA[2][2], vB[2][2];
#define CMP_LOADK(K_, t_) do { _Pragma("unroll") for (int d0_ = 0; d0_ < 4; ++d0_) K_[d0_] = *(const bf16x8*)(KC + (size_t)(t_) * 2048 + ((d0_ * 2 + hi) * 32 + r32) * 8); } while (0)
#define CMP_LOADV(V_, t_) do { _Pragma("unroll") for (int u_ = 0; u_ < 4; ++u_) V_[u_ >> 1][u_ & 1] = *(const bf16x8*)(VCF + (size_t)(t_) * 2048 + ((u_ * 2 + hi) * 32 + r32) * 8); } while (0)
#define CMP_P1(K_, t_) do { f32x16 s = qk_tile(K_, qf); float tm = -INFINITY; \
            _Pragma("unroll") for (int r = 0; r < 16; ++r) { const int n = (t_) * 32 + crow(r, hi); const int dist = tq - (16 * n + 31); s[r] = (dist >= 0 && n < 255) ? s[r] * C2S - slope2 * (float)dist : -INFINITY; tm = fmaxf(tm, s[r]); } \
            tm = fmaxf(tm, __shfl_xor(tm, 32)); \
            const float mn = fmaxf(m, tm), ms_ = (mn == -INFINITY) ? 0.f : mn; float ps = 0.f; \
            _Pragma("unroll") for (int r = 0; r < 16; ++r) ps += __builtin_amdgcn_exp2f(s[r] - ms_); \
            l = l * __builtin_amdgcn_exp2f(m - ms_) + ps; m = mn; } while (0)
        if (nt > 0) {
            CMP_LOADK(kA, 0);
#pragma unroll 1
            for (int t = 0;; t += 2) {
                CMP_LOADK(kB, t + 1 < nt ? t + 1 : nt - 1); CMP_P1(kA, t); if (t + 1 >= nt) break;
                CMP_LOADK(kA, t + 2 < nt ? t + 2 : nt - 1); CMP_P1(kB, t + 1); if (t + 2 >= nt) break;
            }
        }
        l += __shfl_xor(l, 32);
        const float inv = 1.0f / fmaxf(l, 1e-30f), ms = (m == -INFINITY) ? 0.f : m;
        f32x16 o0, o1;
#pragma unroll
        for (int r = 0; r < 16; ++r) { o0[r] = 0.f; o1[r] = 0.f; }
#define CMP_P2(K_, V_, t_) do { f32x16 s = qk_tile(K_, qf); \
            _Pragma("unroll") for (int r = 0; r < 16; ++r) { const int n = (t_) * 32 + crow(r, hi); const int dist = tq - (16 * n + 31); \
                s[r] = (dist >= 0 && n < 255) ? __builtin_amdgcn_exp2f(s[r] * C2S - slope2 * (float)dist - ms) * inv : 0.f; } \
            { float pt_[4]; _Pragma("unroll") for (int a4 = 0; a4 < 4; ++a4) pt_[a4] = __shfl_xor(s[4 * a4 + 3], 32);        \
              _Pragma("unroll") for (int a4 = 0; a4 < 4; ++a4) { const float bs = (s[4 * a4] + s[4 * a4 + 1]) + (s[4 * a4 + 2] + s[4 * a4 + 3]); \
                  const float ad = hi ? pt_[a4] : (a4 ? pt_[a4 ? a4 - 1 : 0] : carry); imps[r32 * 65 + 8 * (t_) + 2 * a4 + hi] = bs + ad; } \
              carry = pt_[3]; } \
            unsigned pk[8]; \
            _Pragma("unroll") for (int j = 0; j < 8; ++j) pk[j] = pg8::cvt_pk_bf16(s[2 * j], s[2 * j + 1]); \
            _Pragma("unroll") for (int i = 0; i < 2; ++i) { const bf16x8 pb = __builtin_bit_cast(bf16x8, (v4u){pk[4 * i], pk[4 * i + 1], pk[4 * i + 2], pk[4 * i + 3]}); \
                o0 = __builtin_amdgcn_mfma_f32_32x32x16_bf16(V_[0][i], pb, o0, 0, 0, 0); o1 = __builtin_amdgcn_mfma_f32_32x32x16_bf16(V_[1][i], pb, o1, 0, 0, 0); } } while (0)
        float carry = 0.f;
        if (nt > 0) {
            CMP_LOADK(kA, 0); CMP_LOADV(vA, 0);
#pragma unroll 1
            for (int t = 0;; t += 2) {
                { const int tn = t + 1 < nt ? t + 1 : nt - 1; CMP_LOADK(kB, tn); CMP_LOADV(vB, tn); } CMP_P2(kA, vA, t); if (t + 1 >= nt) break;
                { const int tn = t + 2 < nt ? t + 2 : nt - 1; CMP_LOADK(kA, tn); CMP_LOADV(vA, tn); } CMP_P2(kB, vB, t + 1); if (t + 2 >= nt) break;
            }
        }
#undef CMP_LOADK
#undef CMP_LOADV
#undef CMP_P1
#undef CMP_P2
        if (nt > 0 && nt < 8 && hi == 0) imps[r32 * 65 + 8 * nt] = carry;
        const float g0 = sigmoidf_(ZS[(rowb + tq) * 16 + 4 + h * 3 + 0]);
        store_ot_bf16((bf16*)(a->ws + WS_OCB) + (rowb + tq) * 256 + h * 64, o0, o1, g0, hi);
    }
    asm volatile("s_waitcnt lgkmcnt(0)" ::: "memory");
}
__device__ __forceinline__ void fa_cmp_topk(CArgsP a, int b, int qt, LAS float* imps, LAS unsigned long long* kl  , int tok0, int ntok, int lane_in) {
    int lane = lane_in; asm volatile("" : "+v"(lane));
    unsigned long long mymask = 0ull; const int curb = qt >> 1;
    const bool causal = lane <= curb; const bool forced = (lane == 0) || (lane == curb) || (lane == curb - 1);
    if (curb < 16) { if (lane < ntok) ((unsigned long long*)(a->ws + WS_MASK))[(size_t)b * SEQ + qt * 32 + tok0 + lane] = (2ull << curb) - 1ull; return; }
    for (int tt = tok0; tt < tok0 + ntok; tt += 2) {
        const float impA = (imps[tt * 65 + lane] + imps[2080 + tt * 65 + lane]) + (imps[2 * 2080 + tt * 65 + lane] + imps[3 * 2080 + tt * 65 + lane]);
        const float impB = (imps[(tt + 1) * 65 + lane] + imps[2080 + (tt + 1) * 65 + lane]) + (imps[2 * 2080 + (tt + 1) * 65 + lane] + imps[3 * 2080 + (tt + 1) * 65 + lane]);
        const unsigned long long keyA = causal ? (((unsigned long long)(forced ? 0x7f800000u : __float_as_uint(impA)) << 32) | (unsigned)(63 - lane)) : 0ull;
        const unsigned long long keyB = causal ? (((unsigned long long)(forced ? 0x7f800000u : __float_as_uint(impB)) << 32) | (unsigned)(63 - lane)) : 0ull;
        kl[lane] = keyA; kl[64 + lane] = keyB;
        int rankA = 0, rankB = 0;
#pragma unroll 2
        for (int jj = 0; jj <= curb; jj += 2) { const v4u twoA = *(const LAS v4u*)(kl + jj), twoB = *(const LAS v4u*)(kl + 64 + jj);
            const unsigned long long a0 = ((unsigned long long)twoA.y << 32) | twoA.x, a1 = ((unsigned long long)twoA.w << 32) | twoA.z;
            const unsigned long long b0 = ((unsigned long long)twoB.y << 32) | twoB.x, b1 = ((unsigned long long)twoB.w << 32) | twoB.z;
            rankA += (a0 > keyA) ? 1 : 0; rankA += (a1 > keyA) ? 1 : 0; rankB += (b0 > keyB) ? 1 : 0; rankB += (b1 > keyB) ? 1 : 0; }
        const unsigned long long mkA = __ballot(rankA < 16 && causal), mkB = __ballot(rankB < 16 && causal);
        if (lane == tt - tok0) mymask = mkA;
        if (lane == tt + 1 - tok0) mymask = mkB;
    }
    if (lane < ntok) ((unsigned long long*)(a->ws + WS_MASK))[(size_t)b * SEQ + qt * 32 + tok0 + lane] = mymask;
    asm volatile("s_waitcnt lgkmcnt(0)" ::: "memory");
}
struct SlcF { int tq; unsigned long long mask; float slope2; bool bit;
    __device__ __forceinline__ void begin_tile(int k0) { bit = (mask >> (k0 >> 6)) & 1ull; }
    __device__ __forceinline__ bool tile_masked(bool diag) const { return diag || !__all(bit); }
    __device__ __forceinline__ float plain(int key, float raw) const { return raw * C2S - slope2 * (float)(tq - key); }
    __device__ __forceinline__ bool valid(int key) const { return bit && key <= tq; } };
struct SlcIt { unsigned long long um; int qt;
    __device__ __forceinline__ int first() const { return um ? 2 * (int)__builtin_ctzll(um) : -1; }
    __device__ __forceinline__ int next(int t) const { if ((t & 1) == 0 && t + 1 <= qt) return t + 1; const int j = t >> 1; if (j >= 63) return -1; const unsigned long long rem = um >> (j + 1); return rem ? 2 * (j + 1 + (int)__builtin_ctzll(rem)) : -1; }
    __device__ __forceinline__ bool masked(int t) const { return t == qt; }
    __device__ __forceinline__ bool block_ok(int) const { return false; }
    __device__ __forceinline__ int clampt(int t) const { return t; } };
__device__ __forceinline__ void fa_nsa_item(CArgsP a, int bh, int qt, int lane_in) {
    int lane = lane_in; asm volatile("" : "+v"(lane));
    const int b = bh >> 2, h = bh & 3, r32 = lane & 31, hi = lane >> 5; const int tq = qt * 32 + r32; const size_t rowb = (size_t)b * SEQ;
    const bf16* Z = (const bf16*)(a->ws + WS_ZH); const float* ZS = (const float*)(a->ws + WS_ZS);
    const float slope2 = alibi_slope(4 + h) * LOG2E;
    bf16x8 qf[4]; load_frag4(qf, Z + (rowb + tq) * ZP + ZQ_NSA + h * 64, hi);
    const unsigned long long mask = ((const unsigned long long*)(a->ws + WS_MASK))[rowb + tq];
    const float g1 = sigmoidf_(ZS[(rowb + tq) * 16 + 4 + h * 3 + 1]), g2 = sigmoidf_(ZS[(rowb + tq) * 16 + 4 + h * 3 + 2]);
    const bf16* oc = (const bf16*)(a->ws + WS_OCB) + (rowb + tq) * 256 + h * 64; bf16* ob = (bf16*)(a->ws + WS_O) + (rowb + tq) * DM + (4 + h) * 64;
    {
        FA st; fa_init(st);
        const bf16* vtl = (const bf16*)(a->ws + WS_VF_NS) + (size_t)b * 128 * 2048; const bf16* Kb = (const bf16*)(a->ws + WS_KF_NS) + (size_t)b * 128 * 2048;
        const SlcF f{tq, mask, slope2, false};
        const int curb = qt >> 1; unsigned long long um = 0ull;
        for (int j = 0; j <= curb; ++j) if (__any((mask >> j) & 1ull)) um |= 1ull << j;
        fa_stream<false, true, true>(st, qf, Kb, (size_t)ZP, vtl, (size_t)SEQ, nullptr, SlcIt{um, qt}, r32, hi, f);
        const float l = st.l + __shfl_xor(st.l, 32); const float sc = g1 / fmaxf(l, 1e-30f);
        store_ot_bf16(ob, st.o0, st.o1, sc, hi);
    }
    asm volatile("" ::: "memory");
    {
        FA st; fa_init(st);
        const bf16* vtl = (const bf16*)(a->ws + WS_VF_NW) + (size_t)b * 128 * 2048;
        int tlo = qt * 32 - 511; tlo = tlo < 0 ? 0 : tlo >> 5;
        fa_stream<false, true, true>(st, qf, (const bf16*)(a->ws + WS_KF_NW) + (size_t)b * 128 * 2048, (size_t)ZP, vtl, (size_t)SEQ, nullptr, RangeIt{tlo, qt, band_tfull(qt * 32, 511)}, r32, hi, BandF{tq, 511, slope2});
        const float l = st.l + __shfl_xor(st.l, 32); const float sc = g2 / l;
#pragma unroll
        for (int a4 = 0; a4 < 4; ++a4) { const u32x2_t x = *(const u32x2_t*)(oc + 8 * a4 + 4 * hi), y = *(const u32x2_t*)(oc + 32 + 8 * a4 + 4 * hi);
            const u32x2_t x2 = *(const u32x2_t*)(ob + 8 * a4 + 4 * hi), y2 = *(const u32x2_t*)(ob + 32 + 8 * a4 + 4 * hi);
            st.o0[4 * a4] = st.o0[4 * a4] * sc + (bflo(x.x) + bflo(x2.x)); st.o0[4 * a4 + 1] = st.o0[4 * a4 + 1] * sc + (bfhi(x.x) + bfhi(x2.x)); st.o0[4 * a4 + 2] = st.o0[4 * a4 + 2] * sc + (bflo(x.y) + bflo(x2.y)); st.o0[4 * a4 + 3] = st.o0[4 * a4 + 3] * sc + (bfhi(x.y) + bfhi(x2.y));
            st.o1[4 * a4] = st.o1[4 * a4] * sc + (bflo(y.x) + bflo(y2.x)); st.o1[4 * a4 + 1] = st.o1[4 * a4 + 1] * sc + (bfhi(y.x) + bfhi(y2.x)); st.o1[4 * a4 + 2] = st.o1[4 * a4 + 2] * sc + (bflo(y.y) + bflo(y2.y)); st.o1[4 * a4 + 3] = st.o1[4 * a4 + 3] * sc + (bfhi(y.y) + bfhi(y2.y)); }
        store_ot_bf16(ob, st.o0, st.o1, 1.0f, hi);
    }
}
#define GAS __attribute__((address_space(1)))
typedef GAS unsigned gu32;
#define XB_TMO      128
#define XB_XCNT(j)  (256  + 64 * (j))
#define XB_XSUB(j)  (1280 + 64 * (j))
#define XB_XGEN(j)  (2304 + 64 * (j))
#define XB_TOP      3328
#define XB_TOPGEN   3392
#define XCD_BAR_WORDS 3456
#define XB_SPIN_CAP (1u << 18)

__device__ __forceinline__ unsigned xb_ld(unsigned* p)              { return __hip_atomic_load(p, __ATOMIC_RELAXED, __HIP_MEMORY_SCOPE_AGENT); }
__device__ __forceinline__ unsigned xb_add(unsigned* p, unsigned v) { return __hip_atomic_fetch_add(p, v, __ATOMIC_RELAXED, __HIP_MEMORY_SCOPE_AGENT); }
__device__ __forceinline__ unsigned xb_xcc_id() { return (unsigned)__builtin_amdgcn_s_getreg((3 << 11) | 20) & 0xFu; }
#define XB_SPIN(cond, bar) do { unsigned _sp = 0; while (cond) { __builtin_amdgcn_s_sleep(1); \
    if ((++_sp & 255u) == 0u) { if (xb_ld(&(bar)[XB_TMO])) break; if (_sp > XB_SPIN_CAP) { atomicAdd(&(bar)[XB_TMO], 1u); break; } } } } while (0)

struct XcdBarrier {
    unsigned* bar; unsigned x;
    volatile LAS unsigned* st;
};

__device__ __forceinline__ XcdBarrier xcd_barrier_post(unsigned* bar, volatile LAS unsigned* st) {
    XcdBarrier b; b.bar = bar; b.x = xb_xcc_id(); b.st = st;
    if (threadIdx.x == 0) (void)xb_add(&bar[XB_XCNT(b.x)], 1u);
    return b;
}
__device__ __forceinline__ void xcd_barrier_complete(unsigned* bar, unsigned x, unsigned& nloc, unsigned& nx) {
    const unsigned G = gridDim.x * gridDim.y * gridDim.z;
    unsigned sum, cnt, mine, sp = 0u;
    for (;;) {
        sum = 0u; cnt = 0u; mine = 0u;
#pragma unroll
        for (unsigned j = 0; j < 16; ++j) { const unsigned c = xb_ld(&bar[XB_XCNT(j)]); sum += c; cnt += (c > 0u) ? 1u : 0u; mine = (j == x) ? c : mine; }
        if (sum == G) break;
        __builtin_amdgcn_s_sleep(1);
        if ((++sp & 255u) == 0u) { if (xb_ld(&bar[XB_TMO])) break; if (sp > XB_SPIN_CAP) { atomicAdd(&bar[XB_TMO], 1u); break; } }
    }
    nloc = mine > 0u ? mine : 1u; nx = cnt > 0u ? cnt : 1u;
}

__device__ __forceinline__ void xcd_barrier(const XcdBarrier& b) {
    asm volatile("s_waitcnt vmcnt(0)" ::: "memory");
    __syncthreads();
    if (threadIdx.x == 0) {
        unsigned* bar = b.bar;
        __builtin_amdgcn_s_waitcnt(0);
        unsigned nloc = b.st[0], nx = b.st[1];
        if (nloc == 0u) { xcd_barrier_complete(bar, b.x, nloc, nx); b.st[0] = nloc; b.st[1] = nx; }
        const unsigned old = xb_add(&bar[XB_XSUB(b.x)], 1u);
        const unsigned gen = old / nloc;
        if (old + 1u == (gen + 1u) * nloc) {
            __builtin_amdgcn_fence(__ATOMIC_RELEASE, "agent");
            asm volatile("s_waitcnt vmcnt(0)" ::: "memory");
            const unsigned og = xb_add(&bar[XB_TOP], 1u);
            const unsigned tg = og / nx;
            if (og + 1u == (tg + 1u) * nx) xb_add(&bar[XB_TOPGEN], 1u);
            else XB_SPIN(xb_ld(&bar[XB_TOPGEN]) == tg, bar);
            __builtin_amdgcn_fence(__ATOMIC_ACQUIRE, "agent");
            xb_add(&bar[XB_XGEN(b.x)], 1u);
            asm volatile("s_waitcnt vmcnt(0)" ::: "memory");
        } else {
            XB_SPIN(xb_ld(&bar[XB_XGEN(b.x)]) == gen, bar);
            __builtin_amdgcn_fence(__ATOMIC_ACQUIRE, "agent");
            asm volatile("s_waitcnt vmcnt(0)" ::: "memory");
        }
    }
    __syncthreads();
}

constexpr size_t WS_BAR = WS_DL + 1536 * 1024;
static_assert(WS_BAR + XCD_BAR_WORDS * 4 <= WS_END, "barrier words inside the small region");
constexpr int LDS_BARST = LDS_BYTES - 64;
#define GRID_BAR() do { CArgsP bp_ = (CArgsP)__builtin_amdgcn_kernarg_segment_ptr(); asm volatile("" : "+s"(bp_)); XcdBarrier xb_; xb_.bar = (unsigned*)(bp_->ws + WS_BAR); xb_.x = xb_xcc_id(); \
    xb_.st = (volatile LAS unsigned*)(lds + LDS_BARST); xcd_barrier(xb_); } while (0)
#define PHASE_ARGS() asm volatile("; PHASE_MARK line %0" :: "i"(__LINE__)); CArgsP ap_ = (CArgsP)__builtin_amdgcn_kernarg_segment_ptr(); asm volatile("" : "+s"(ap_)); \
    CArgsP a = ap_; unsigned char* ws = a->ws; bf16* ZH = (bf16*)(ws + WS_ZH); bf16* XG = (bf16*)(ws + WS_XG); bf16* OB = (bf16*)(ws + WS_O); float* SSQ = (float*)(ws + WS_SSQ); float* ZS = (float*)(ws + WS_ZS); float* X = a->out; \
    (void)ZH; (void)XG; (void)OB; (void)SSQ; (void)ZS; (void)X; int ln = threadIdx.x; asm volatile("" : "+v"(ln)); ln &= 63;
__global__ void __launch_bounds__(NTHR, 2) fwd_megakernel(Args a_unused) {
    extern __shared__ __attribute__((aligned(16))) unsigned char lds_raw[];
    LAS unsigned char* lds = (LAS unsigned char*)lds_raw;
    const int wave = __builtin_amdgcn_readfirstlane(threadIdx.x >> 6);
    const int G = gridDim.x, gw = blockIdx.x * NWAVES + wave, NGW = G * NWAVES;
    const int vcu = (G % 8 == 0) ? (int)(blockIdx.x % 8) * (G / 8) + (int)(blockIdx.x / 8) : (int)blockIdx.x;
    const int gv = vcu * NWAVES + wave;

    if (threadIdx.x < 2) ((LAS unsigned*)(lds + LDS_BARST))[threadIdx.x] = 0u;
    __syncthreads();
    { CArgsP bp_ = (CArgsP)__builtin_amdgcn_kernarg_segment_ptr(); (void)xcd_barrier_post((unsigned*)(bp_->ws + WS_BAR), (volatile LAS unsigned*)(lds + LDS_BARST)); }
    for (int rp = 0; rp < REP_PRO; ++rp)
    { PHASE_ARGS(); prologue(a, lds, gw, NGW, wave, ln); }
    cg::this_grid().sync();

    for (int l = 0; l < DEPTH; ++l) {
        const size_t wlo = WS_W + (size_t)l * LAYER_W;
#if GSEL & 1
        for (int rep = 0; rep < REP_G1; ++rep)
        { PHASE_ARGS(); pg8::Gemm g{XG, (const bf16*)(ws + wlo + OFF_WGU1), M, NGU, DM}; pg8::StaticOrder S; S.init(M, NGU, G, (int)blockIdx.x);
          pg8::EpiSwiglu E{ZH, SSQ, DFF};
          pg8::gemm_phase<pg8::EpiSwiglu, pg8::StaticOrder, true, true>(lds, g, S, E); }
#endif
        GRID_BAR();
#if GSEL & 2
        { PHASE_ARGS(); pg8::Gemm g{ZH, (const bf16*)(ws + wlo + OFF_WD1), M, DM, DFF}; pg8::StaticOrder S; S.init(M, DM, G, (int)blockIdx.x);
          pg8::EpiResid E{l == 0 ? a->in[0] : X, X, XG, a->in[5] + l * DM, SSQ, 0.5f};
          pg8::gemm_phase<pg8::EpiResid, pg8::StaticOrder, true, true>(lds, g, S, E); }
#endif
        GRID_BAR();
#if GSEL & 4
        { PHASE_ARGS(); pg8::Gemm g{XG, (const bf16*)(ws + wlo + OFF_WIN), M, ZP, DM}; pg8::StaticOrder S; S.init(M, ZP, G, (int)blockIdx.x);
          pg8::EpiZ E{ZH, ZS, SSQ, ZP, (bf16*)(ws + WS_KF_FOX)};
          pg8::gemm_phase<pg8::EpiZ, pg8::StaticOrder, true, true>(lds, g, S, E); }
#endif
        GRID_BAR();
        for (int rep = 0; rep < REP_P4; ++rep) {
        { PHASE_ARGS();
          for (int it = blockIdx.x; it < 32 + 256; it += G) { if (it < 32) p4_cumsum(a, l, lds, it); else p4_compress(a, l, lds, it - 32); }
          for (int it = gw; it < 14336; it += NGW) p4_vfrag2_item(a, it, (LAS unsigned short*)(lds + wave * 16640), ln);
          for (int it = gw; it < 2048; it += NGW) p4_kfrag_item(a, it, ln);
          for (int it = gw; it < 6144; it += NGW) p4_vfrag_item(a, it, (LAS unsigned short*)(lds + wave * 16640), ln);
#if !FA_DIL
          for (int it = gw; it < 6144; it += NGW) p4_dil_item(a, it, ln);
#endif
#if !FA_SWA
          for (int it = gw; it < 2048; it += NGW) p4_swa_item(a, l, it, ln);
#endif
        }
        GRID_BAR(); }
        for (int rep = 0; rep < REP_P5; ++rep) {
        { PHASE_ARGS();
#if FA_FOX
          for (int rp = 0; rp < REP_FOX; ++rp)
          for (int i = gv; i < 2048; i += NGW) { fa_fox_item(a, i >> 6, 127 - (i & 63), ln); fa_fox_item(a, i >> 6, i & 63, ln); }
#else
          for (int it = gw; it < 2048; it += NGW) p5_fox_item(a, it, ln);
#endif
#if FA_CMP
          for (int rp = 0; rp < REP_CMP; ++rp)
          for (int rd = vcu; rd < 256; rd += G) {
              const int cb = rd >> 5, ck = rd & 31, slot = wave >> 1, hp = wave & 1;
#define CMP_QT(s_) ((s_) == 0 ? ck : ((s_) == 1 ? 63 - ck : ((s_) == 2 ? 64 + ck : 127 - ck)))
              const int cqt = CMP_QT(slot);
              LAS float* imps = (LAS float*)(lds + slot * 4 * 8320);
              for (int rq = 0; rq < REP_CPASS; ++rq)
              { const int hh = wave & 3, s1 = wave < 4 ? 3 : 2, s2 = wave < 4 ? 0 : 1;
                fa_cmp_passes(a, cb, CMP_QT(s1), hh, hh + 1, (LAS float*)(lds + (s1 * 4 + hh) * 8320), ln);
                fa_cmp_passes(a, cb, CMP_QT(s2), hh, hh + 1, (LAS float*)(lds + (s2 * 4 + hh) * 8320), ln); }
#undef CMP_QT
              __syncthreads();
              for (int rq = 0; rq < REP_CTOPK; ++rq) fa_cmp_topk(a, cb, cqt, imps, (LAS unsigned long long*)(lds + 133120 + wave * 1024), 16 * hp, 16, ln);
              __syncthreads();
          }
#else
          for (int it = gw; it < 512; it += NGW) p5_cmp_item(a, it, (LAS float*)(lds + wave * 16640), ln);
#endif
#if FA_SWA
          for (int it = gv; it < 4096; it += NGW) fa_swa_item(a, l, it, ln);
#endif
#if FA_DIL
          for (int rp = 0; rp < REP_DIL; ++rp)
          for (int it = gv; it < 12288; it += NGW) fa_dil_item(a, it, ln);
#else
          for (int it = gw; it < 2048; it += NGW) p5_dilcomb_item(a, it, ln);
#endif
        }
        GRID_BAR(); }
        for (int rep = 0; rep < REP_P6; ++rep) {
        { PHASE_ARGS();
#if FA_NSA
          for (int i = gv; i < 2048; i += NGW) { fa_nsa_item(a, i >> 6, 127 - (i & 63), ln); fa_nsa_item(a, i >> 6, i & 63, ln); }
#else
          for (int it = gw; it < 2048; it += NGW) p6_nsa_item(a, it, ln);
#endif
#if FA_DIL
          for (int it = gw; it < 2048; it += NGW) p5_dilcomb_item(a, it, ln);
#endif
        }
        GRID_BAR(); }
#if GSEL & 8
        { PHASE_ARGS(); pg8::Gemm g{OB, (const bf16*)(ws + wlo + OFF_WOUT), M, DM, DM}; pg8::StaticOrder S; S.init(M, DM, G, (int)blockIdx.x);
          pg8::EpiResid E{X, X, XG, a->in[13] + l * DM, SSQ, 1.0f};
          pg8::gemm_phase<pg8::EpiResid, pg8::StaticOrder, true, true>(lds, g, S, E); }
#endif
        GRID_BAR();
#if GSEL & 1
        { PHASE_ARGS(); pg8::Gemm g{XG, (const bf16*)(ws + wlo + OFF_WGU2), M, NGU, DM}; pg8::StaticOrder S; S.init(M, NGU, G, (int)blockIdx.x);
          pg8::EpiSwiglu E{ZH, SSQ, DFF};
          pg8::gemm_phase<pg8::EpiSwiglu, pg8::StaticOrder, true, true>(lds, g, S, E); }
#endif
        GRID_BAR();
#if GSEL & 2
        { PHASE_ARGS(); pg8::Gemm g{ZH, (const bf16*)(ws + wlo + OFF_WD2), M, DM, DFF}; pg8::StaticOrder S; S.init(M, DM, G, (int)blockIdx.x);
          pg8::EpiResid E{X, X, XG, l + 1 < DEPTH ? a->in[1] + (l + 1) * DM : a->in[17], SSQ, 0.5f};
          pg8::gemm_phase<pg8::EpiResid, pg8::StaticOrder, true, true>(lds, g, S, E); }
#endif
        GRID_BAR();
    }
#ifdef EXTRA_SYNCS
    for (int i = 0; i < EXTRA_SYNCS; ++i) GRID_BAR();
#endif
    { PHASE_ARGS(); const int lane = ln; const float* gf = a->in[17]; f32x4 gv[4];
#pragma unroll
      for (int j = 0; j < 4; ++j) gv[j] = *(const f32x4*)(gf + 4 * lane + 256 * j);
      for (int m = gw; m < M; m += NGW) {
          const f32x4 p = *(const f32x4*)(SSQ + (size_t)m * 16 + 4 * (lane & 3)); float s = (p[0] + p[1]) + (p[2] + p[3]); s += __shfl_xor(s, 1); s += __shfl_xor(s, 2);
          const float rs = 1.0f / sqrtf(s * (1.0f / 1024.0f) + 1e-6f);
          f32x4* xr = (f32x4*)(X + (size_t)m * DM) + lane;
#pragma unroll
          for (int j = 0; j < 4; ++j) { f32x4 v = xr[64 * j]; v = v * gv[j] * rs; xr[64 * j] = v; } } }
}

extern "C" void kernel_launch(void* const* d_in, const int* in_sizes, int n_in, void* d_out, int out_size, void* d_ws, size_t ws_size, hipStream_t stream) {
    static int grid = 0;
    if (grid == 0) {
        if (n_in != 18 || out_size != M * DM || ws_size < 512 * MiB) { fprintf(stderr, "kernel_launch: unexpected shapes (n_in %d out %d ws %zu)\n", n_in, out_size, ws_size); grid = -1; return; }
        int dev = 0, cus = 0, per_cu = 0;
        (void)hipGetDevice(&dev); (void)hipDeviceGetAttribute(&cus, hipDeviceAttributeMultiprocessorCount, dev);
        if (hipFuncSetAttribute((const void*)fwd_megakernel, hipFuncAttributeMaxDynamicSharedMemorySize, LDS_BYTES) != hipSuccess) { fprintf(stderr, "hipFuncSetAttribute failed\n"); grid = -1; return; }
        if (hipOccupancyMaxActiveBlocksPerMultiprocessor(&per_cu, (const void*)fwd_megakernel, NTHR, LDS_BYTES) != hipSuccess || per_cu < 1) { fprintf(stderr, "occupancy query: %d\n", per_cu); per_cu = 1; }
        (void)hipGetLastError();
        grid = cus;
        if (grid <= 0) grid = 256;
    }
    if (grid < 0) return;
    if (hipMemsetAsync((char*)d_ws + WS_BAR, 0, XCD_BAR_WORDS * 4, stream) != hipSuccess) { fprintf(stderr, "memset of the barrier words failed\n"); return; }
    Args a{};
    for (int i = 0; i < 18; ++i) a.in[i] = (const float*)d_in[i];
    a.out = (float*)d_out; a.ws = (unsigned char*)d_ws;
    void* args[] = {&a};
    hipError_t e = hipLaunchCooperativeKernel((const void*)fwd_megakernel, dim3(grid), dim3(NTHR), args, LDS_BYTES, stream);
    if (e != hipSuccess) fprintf(stderr, "cooperative launch failed: %s (grid %d)\n", hipGetErrorString(e), grid);
}
```

```cpp
#include <hip/hip_runtime.h>
#include <cstdio>
#include <cstdint>
#include <cmath>
namespace pg8 {
#define PG8_LAS __attribute__((address_space(3)))
typedef unsigned short bf16_t;
typedef short bf16x8 __attribute__((ext_vector_type(8)));
typedef float f32x4 __attribute__((ext_vector_type(4)));
typedef unsigned u32x4 __attribute__((ext_vector_type(4)));
constexpr int BM = 256, BK = 64, HALF = 128, HTB = HALF * BK * 2  , STAGE_BYTES = 8 * HTB, NXCD = 8, WGM = 8;

__host__ __device__ __forceinline__ int lds_byte(int r, int c) { const int st = (r >> 4) * 2 + (c >> 5), rr = r & 15, cc = c & 31, ob = rr * 64 + cc * 2; return st * 1024 + (ob ^ (((ob >> 9) & 1) << 5)); }
__host__ __device__ __forceinline__ void stage_rc(int b, int& R, int& C) { const int st = b / 1024, sb = b % 1024, swz = sb ^ (((sb >> 9) & 1) << 5); R = (st >> 1) * 16 + swz / 64; C = (st & 1) * 32 + (swz % 64) / 2; }
__host__ __device__ __forceinline__ int perm32(int rho) { const int n = rho >> 4, i = rho & 15; return 8 * (i >> 2) + 4 * n + (i & 3); }

struct Unit { int pm, pn; };
struct Gemm { const bf16_t* A; const bf16_t* Bt; int M, N, K; };

struct StaticOrder {
    int nM, nN, nwg, G, c;
    __host__ __device__ void init(int M, int N, int G_, int c_) { nM = M / BM; nN = N / BM; nwg = nM * nN; G = G_; c = c_; }
    __host__ __device__ bool next(int i, Unit& u) const {
        const long L = (long)i * G + c; if (L >= nwg) return false;
        int wgid = (int)L; { const int q = nwg / NXCD, r = nwg % NXCD, xcd = wgid % NXCD, off = wgid / NXCD; wgid = (xcd < r ? xcd * (q + 1) : r * (q + 1) + (xcd - r) * q) + off; }
        const int nig = WGM * nN, gid = wgid / nig, fm = gid * WGM, gsz = (nM - fm) < WGM ? (nM - fm) : WGM;
        u.pm = fm + ((wgid % nig) % gsz); u.pn = (wgid % nig) / gsz; return true;
    }
    __device__ __forceinline__ void a_ready(const Unit&) const {}
    __device__ __forceinline__ void done(const Unit&) const {}
};

__device__ __forceinline__ unsigned cvt_pk_bf16(float lo, float hi) { unsigned r; asm volatile("v_cvt_pk_bf16_f32 %0, %1, %2" : "=v"(r) : "v"(lo), "v"(hi)); return r; }
typedef float f32x2 __attribute__((ext_vector_type(2)));
constexpr float RMS_EPS_F = 1e-6f;
typedef unsigned u32x2 __attribute__((ext_vector_type(2)));
__device__ __forceinline__ float row_rstd(const float* ssq, int row, int fq) {
    const f32x4 p = *(const f32x4*)(ssq + (size_t)row * 16 + 4 * fq);
    float s = (p[0] + p[1]) + (p[2] + p[3]);
    s += __shfl_xor(s, 16); s += __shfl_xor(s, 32);
    return 1.0f / sqrtf(s * (1.0f / 1024.0f) + RMS_EPS_F);
}
__device__ __forceinline__ void row_rstd8(float (&rs)[2][4], const float* ssq, int row0, int fq) {
    f32x4 p[2][4];
#pragma unroll
    for (int ai = 0; ai < 2; ++ai)
#pragma unroll
        for (int m = 0; m < 4; ++m) p[ai][m] = *(const f32x4*)(ssq + (size_t)(row0 + ai * HALF + m * 16) * 16 + 4 * fq);
#pragma unroll
    for (int ai = 0; ai < 2; ++ai)
#pragma unroll
        for (int m = 0; m < 4; ++m) { float s = (p[ai][m][0] + p[ai][m][1]) + (p[ai][m][2] + p[ai][m][3]); s += __shfl_xor(s, 16); s += __shfl_xor(s, 32); rs[ai][m] = 1.0f / sqrtf(s * (1.0f / 1024.0f) + RMS_EPS_F); }
}
__device__ __forceinline__ float silu_mul(float g, float u) { return g * u * __builtin_amdgcn_rcpf(1.0f + __expf(-g)); }
struct EpiSwiglu {
    static constexpr bool PERM = true, AFTER_DRAIN = false;
    bf16_t* H; const float* ssq; int ldh;
    __device__ __forceinline__ void operator()(const f32x4 (&acc)[2][2][4][2], const Unit& u, int wr, int wc, int fr, int fq) const {
        const int row0 = u.pm * BM + wr * 64 + fr; const int col0 = u.pn * HALF + wc * 32 + 8 * fq;
        float rsv[2][4]; row_rstd8(rsv, ssq, row0, fq);
#pragma unroll
        for (int ai = 0; ai < 2; ++ai)
#pragma unroll
            for (int m = 0; m < 4; ++m) {
                const int row = row0 + ai * HALF + m * 16; const float rs = rsv[ai][m];
                const f32x4 g0 = acc[ai][0][m][0] * rs, g1 = acc[ai][0][m][1] * rs, u0 = acc[ai][1][m][0] * rs, u1 = acc[ai][1][m][1] * rs;
                u32x4 w; w.x = cvt_pk_bf16(silu_mul(g0[0], u0[0]), silu_mul(g0[1], u0[1])); w.y = cvt_pk_bf16(silu_mul(g0[2], u0[2]), silu_mul(g0[3], u0[3]));
                w.z = cvt_pk_bf16(silu_mul(g1[0], u1[0]), silu_mul(g1[1], u1[1])); w.w = cvt_pk_bf16(silu_mul(g1[2], u1[2]), silu_mul(g1[3], u1[3]));
                *(u32x4*)(H + (size_t)row * ldh + col0) = w;
            }
    }
};
struct EpiResid {
    static constexpr bool PERM = true, AFTER_DRAIN = false;
    const float* base; float* xout; bf16_t* XG; const float* gnext; float* ssq; float alpha;
    __device__ __forceinline__ void operator()(const f32x4 (&acc)[2][2][4][2], const Unit& u, int wr, int wc, int fr, int fq) const {
        const int row0 = u.pm * BM + wr * 64 + fr; const int col0 = u.pn * BM + wc * 32 + 8 * fq;
        f32x4 gv[2][2];
#pragma unroll
        for (int bj = 0; bj < 2; ++bj)
#pragma unroll
            for (int n = 0; n < 2; ++n) gv[bj][n] = *(const f32x4*)(gnext + col0 + bj * HALF + 4 * n);
#pragma unroll
        for (int ai = 0; ai < 2; ++ai)
#pragma unroll
            for (int m = 0; m < 4; ++m) {
                const int row = row0 + ai * HALF + m * 16; float ss = 0.f;
#pragma unroll
                for (int bj = 0; bj < 2; ++bj) {
                    const size_t off = (size_t)row * 1024 + col0 + bj * HALF;
                    const f32x4 b0 = *(const f32x4*)(base + off), b1 = *(const f32x4*)(base + off + 4);
                    const f32x4 v0 = b0 + acc[ai][bj][m][0] * alpha, v1 = b1 + acc[ai][bj][m][1] * alpha;
                    *(f32x4*)(xout + off) = v0; *(f32x4*)(xout + off + 4) = v1;
                    ss += (v0[0] * v0[0] + v0[1] * v0[1]) + (v0[2] * v0[2] + v0[3] * v0[3]) + (v1[0] * v1[0] + v1[1] * v1[1]) + (v1[2] * v1[2] + v1[3] * v1[3]);
                    const f32x4 y0 = v0 * gv[bj][0], y1 = v1 * gv[bj][1];
                    u32x4 w; w.x = cvt_pk_bf16(y0[0], y0[1]); w.y = cvt_pk_bf16(y0[2], y0[3]); w.z = cvt_pk_bf16(y1[0], y1[1]); w.w = cvt_pk_bf16(y1[2], y1[3]);
                    *(u32x4*)(XG + off) = w;
                }
                ss += __shfl_xor(ss, 16); ss += __shfl_xor(ss, 32);
                if (fq == 0) ssq[(size_t)row * 16 + u.pn * 4 + wc] = ss;
                if (m & 1) asm volatile("" ::: "memory");
            }
    }
};
struct EpiZ {
    static constexpr bool PERM = true, AFTER_DRAIN = false;
    bf16_t* Z; float* ZS; const float* ssq; int ldz; bf16_t* KF; bf16_t* KFS; bf16_t* KFW;
    __device__ __forceinline__ void operator()(const f32x4 (&acc)[2][2][4][2], const Unit& u, int wr, int wc, int fr, int fq) const {
        const int row0 = u.pm * BM + wr * 64 + fr; const int col0 = u.pn * BM + wc * 32 + 8 * fq;
        const bool small = (u.pn == 10) && (wc == 0) && (fq < 2);
        float rsv[2][4]; row_rstd8(rsv, ssq, row0, fq);
#pragma unroll
        for (int ai = 0; ai < 2; ++ai)
#pragma unroll
            for (int m = 0; m < 4; ++m) {
                const int row = row0 + ai * HALF + m * 16; const float rs = rsv[ai][m];
#pragma unroll
                for (int bj = 0; bj < 2; ++bj) {
                    const f32x4 v0 = acc[ai][bj][m][0] * rs, v1 = acc[ai][bj][m][1] * rs;
                    u32x4 w; w.x = cvt_pk_bf16(v0[0], v0[1]); w.y = cvt_pk_bf16(v0[2], v0[3]); w.z = cvt_pk_bf16(v1[0], v1[1]); w.w = cvt_pk_bf16(v1[2], v1[3]);
                    if (u.pn == 1) { const int cc = bj * HALF + wc * 32 + 8 * fq, tk = row & 4095;
                        *(u32x4*)(KF + ((size_t)(((row >> 12) * 4 + (cc >> 6)) * 128 + (tk >> 5)) * 2048) + ((((cc & 63) >> 3) * 32 + (tk & 31)) * 8)) = w; }
                    else if ((u.pn == 4 && bj == 1 && wc < 2) || (u.pn == 5 && bj == 0 && wc < 2)) { const int cc = wc * 32 + 8 * fq, tk = row & 4095;
                        *(u32x4*)((u.pn == 4 ? KFS : KFW) + ((size_t)((row >> 12) * 128 + (tk >> 5)) * 2048) + (((cc >> 3) * 32 + (tk & 31)) * 8)) = w; }
                    else *(u32x4*)(Z + (size_t)row * ldz + col0 + bj * HALF) = w;
                    if (bj == 1 && small) { *(f32x4*)(ZS + (size_t)row * 16 + 8 * fq) = v0; *(f32x4*)(ZS + (size_t)row * 16 + 8 * fq + 4) = v1; }
                }
            }
    }
};
template <class Epi, class Sched, bool ALIGN_EPI = false, bool SP2 = false>
__device__ __forceinline__ void gemm_phase(PG8_LAS unsigned char* lds, const Gemm g, const Sched& S, const Epi& E) {
    int tid_ = threadIdx.x; asm volatile("" : "+v"(tid_));
    const int tid = tid_, wid = __builtin_amdgcn_readfirstlane(tid >> 6), lane = tid & 63, wr = wid >> 2, wc = wid & 3, fr = lane & 15, fq = lane >> 4;
    const int K = g.K, nt = K / BK;
    unsigned voffA[2], voffB[2];
#pragma unroll
    for (int i = 0; i < 2; ++i) { int R, C; stage_rc(tid * 16 + i * 8192, R, C); const int Rb = Epi::PERM ? ((R & ~31) + perm32(R & 31)) : R;
        voffA[i] = (unsigned)(R * K + C) * 2u; voffB[i] = (unsigned)(Rb * K + C) * 2u; }
    const size_t kstep = (size_t)(BK * 2);
    const size_t hstep = (size_t)HALF * K * 2;
    const size_t tstep = 2 * hstep;
    const unsigned ldsw = (unsigned)wid * 1024u;
    const int aoff = lds_byte(wr * 64 + fr, fq * 8), boff = lds_byte(wc * 32 + fr, fq * 8);
#define PG8_SA(b, h) (((b) * 2 + (h)) * HTB)
#define PG8_SB(b, h) ((4 + (b) * 2 + (h)) * HTB)
#define PG8_STAGE(bufoff, gbase, voff) do { _Pragma("unroll") for (int _i = 0; _i < 2; ++_i) \
        __builtin_amdgcn_global_load_lds((const unsigned*)((const char*)(gbase) + (voff)[_i]), (PG8_LAS unsigned*)(lds + (bufoff) + ldsw + _i * 8192), 16, 0, 0); } while (0)
#define PG8_LDA(dst, b, h) do { _Pragma("unroll") for (int m = 0; m < 4; ++m) _Pragma("unroll") for (int k = 0; k < 2; ++k) dst[m][k] = *(const PG8_LAS bf16x8*)(lds + PG8_SA(b, h) + aoff + m * 2048 + k * 1024); } while (0)
#define PG8_LDB(dst, b, h) do { _Pragma("unroll") for (int n = 0; n < 2; ++n) _Pragma("unroll") for (int k = 0; k < 2; ++k) dst[n][k] = *(const PG8_LAS bf16x8*)(lds + PG8_SB(b, h) + boff + n * 2048 + k * 1024); } while (0)
#define PG8_MMA(ai, bj, At, Bt) do { __builtin_amdgcn_s_setprio(1); _Pragma("unroll") for (int m = 0; m < 4; ++m) _Pragma("unroll") for (int n = 0; n < 2; ++n) _Pragma("unroll") for (int k = 0; k < 2; ++k) \
        acc[ai][bj][m][n] = __builtin_amdgcn_mfma_f32_16x16x32_bf16(Bt[n][k], At[m][k], acc[ai][bj][m][n], 0, 0, 0); __builtin_amdgcn_s_setprio(0); } while (0)
#define PG8_WAIT_V(n) asm volatile("s_waitcnt vmcnt(" #n ")" ::: "memory")
#define PG8_WAIT_L(n) asm volatile("s_waitcnt lgkmcnt(" #n ")" ::: "memory")
#define PG8_BAR __builtin_amdgcn_s_barrier()
#define PG8_SCHED __builtin_amdgcn_sched_barrier(0)
    Unit cur, nxt; int ui = 0;
    if (!S.next(0, cur)) return;
    f32x4 acc[2][2][4][2];
#pragma unroll
    for (int a = 0; a < 2; ++a)
#pragma unroll
        for (int b = 0; b < 2; ++b)
#pragma unroll
            for (int m = 0; m < 4; ++m)
#pragma unroll
                for (int n = 0; n < 2; ++n) acc[a][b][m][n] = (f32x4){0.f, 0.f, 0.f, 0.f};
    bf16x8 At[4][2], B0[2][2], B1[2][2];
    const char* cA = (const char*)g.A + (size_t)cur.pm * tstep; const char* cB = (const char*)g.Bt + (size_t)cur.pn * tstep;
    S.a_ready(cur);
    if constexpr (SP2) {
        PG8_STAGE(PG8_SB(0, 0), cB, voffB); PG8_STAGE(PG8_SB(0, 1), cB + hstep, voffB); PG8_STAGE(PG8_SA(0, 0), cA, voffA); PG8_STAGE(PG8_SA(0, 1), cA + hstep, voffA);
        if (wr == 1) PG8_BAR;
        PG8_WAIT_V(2); PG8_BAR;
        PG8_STAGE(PG8_SB(1, 0), cB + kstep, voffB); PG8_STAGE(PG8_SA(1, 0), cA + kstep, voffA); PG8_STAGE(PG8_SB(1, 1), cB + hstep + kstep, voffB);
        PG8_WAIT_V(6); PG8_BAR;
    } else {
        PG8_STAGE(PG8_SB(0, 0), cB, voffB); PG8_STAGE(PG8_SA(0, 0), cA, voffA); PG8_STAGE(PG8_SB(0, 1), cB + hstep, voffB); PG8_STAGE(PG8_SA(0, 1), cA + hstep, voffA);
        if (wr == 1) PG8_BAR;
        PG8_WAIT_V(4); PG8_BAR;
        PG8_STAGE(PG8_SB(1, 0), cB + kstep, voffB); PG8_STAGE(PG8_SA(1, 0), cA + kstep, voffA); PG8_STAGE(PG8_SB(1, 1), cB + hstep + kstep, voffB);
        PG8_WAIT_V(6); PG8_BAR;
    }
    for (;;) {
        const bool has_next = S.next(ui + 1, nxt);
        const char* nA = has_next ? (const char*)g.A + (size_t)nxt.pm * tstep : cA; const char* nB = has_next ? (const char*)g.Bt + (size_t)nxt.pn * tstep : cB;
        for (int t = 0; t < nt; t += 2) {
            const bool last = (t == nt - 2);
            const char* a1 = cA + (size_t)(t + 1) * kstep;
            const char* a2 = last ? nA : cA + (size_t)(t + 2) * kstep; const char* b2 = last ? nB : cB + (size_t)(t + 2) * kstep;
            const char* a3 = a2 + kstep; const char* b3 = b2 + kstep;
            if (last && has_next) S.a_ready(nxt);
            if constexpr (SP2) {
            PG8_LDB(B0, 0, 0); PG8_LDB(B1, 0, 1); PG8_SCHED; PG8_LDA(At, 0, 0); PG8_STAGE(PG8_SA(1, 1), a1 + hstep, voffA);
            PG8_WAIT_V(8); PG8_WAIT_L(0); PG8_BAR; PG8_MMA(0, 0, At, B0); PG8_MMA(0, 1, At, B1); PG8_BAR; PG8_SCHED;
            PG8_LDA(At, 0, 1); PG8_STAGE(PG8_SB(0, 0), b2, voffB); PG8_STAGE(PG8_SB(0, 1), b2 + hstep, voffB); PG8_STAGE(PG8_SA(0, 0), a2, voffA);
            PG8_WAIT_V(8); PG8_WAIT_L(0); PG8_BAR; PG8_MMA(1, 0, At, B0); PG8_MMA(1, 1, At, B1); PG8_BAR; PG8_SCHED;
            PG8_LDB(B0, 1, 0); PG8_LDB(B1, 1, 1); PG8_SCHED; PG8_LDA(At, 1, 0); PG8_STAGE(PG8_SA(0, 1), a2 + hstep, voffA);
            PG8_WAIT_V(8); PG8_WAIT_L(0); PG8_BAR; PG8_MMA(0, 0, At, B0); PG8_MMA(0, 1, At, B1); PG8_BAR; PG8_SCHED;
            PG8_LDA(At, 1, 1); PG8_STAGE(PG8_SB(1, 0), b3, voffB); PG8_STAGE(PG8_SB(1, 1), b3 + hstep, voffB); PG8_STAGE(PG8_SA(1, 0), a3, voffA);
            PG8_WAIT_V(8); PG8_WAIT_L(0); PG8_BAR; PG8_MMA(1, 0, At, B0); PG8_MMA(1, 1, At, B1); PG8_BAR; PG8_SCHED;
            } else {
            PG8_LDB(B0, 0, 0); PG8_SCHED; PG8_LDA(At, 0, 0); PG8_STAGE(PG8_SA(1, 1), a1 + hstep, voffA);
            PG8_WAIT_L(8); PG8_BAR; PG8_WAIT_L(0); PG8_MMA(0, 0, At, B0); PG8_BAR; PG8_SCHED;
            PG8_LDB(B1, 0, 1); PG8_STAGE(PG8_SB(0, 0), b2, voffB);
            PG8_BAR; PG8_WAIT_L(0); PG8_MMA(0, 1, At, B1); PG8_BAR;
            PG8_LDA(At, 0, 1); PG8_STAGE(PG8_SA(0, 0), a2, voffA);
            PG8_BAR; PG8_WAIT_L(0); PG8_MMA(1, 0, At, B0); PG8_BAR; PG8_SCHED;
            PG8_STAGE(PG8_SB(0, 1), b2 + hstep, voffB);
            PG8_WAIT_V(6); PG8_BAR; PG8_MMA(1, 1, At, B1); PG8_BAR;
            PG8_LDB(B0, 1, 0); PG8_SCHED; PG8_LDA(At, 1, 0); PG8_STAGE(PG8_SA(0, 1), a2 + hstep, voffA);
            PG8_WAIT_L(8); PG8_BAR; PG8_WAIT_L(0); PG8_MMA(0, 0, At, B0); PG8_BAR; PG8_SCHED;
            PG8_LDB(B1, 1, 1); PG8_STAGE(PG8_SB(1, 0), b3, voffB);
            PG8_BAR; PG8_WAIT_L(0); PG8_MMA(0, 1, At, B1); PG8_BAR;
            PG8_LDA(At, 1, 1); PG8_STAGE(PG8_SA(1, 0), a3, voffA);
            PG8_BAR; PG8_WAIT_L(0); PG8_MMA(1, 0, At, B0); PG8_BAR; PG8_SCHED;
            PG8_STAGE(PG8_SB(1, 1), b3 + hstep, voffB);
            PG8_WAIT_V(6); PG8_BAR; PG8_MMA(1, 1, At, B1); PG8_BAR;
            }
        }
        if constexpr (ALIGN_EPI) { if (wr == 0) PG8_BAR; }
        if constexpr (!Epi::AFTER_DRAIN) { E(acc, cur, wr, wc, fr, fq); S.done(cur); }
        if (!has_next) break;
#pragma unroll
        for (int a = 0; a < 2; ++a)
#pragma unroll
            for (int b = 0; b < 2; ++b)
#pragma unroll
                for (int m = 0; m < 4; ++m)
#pragma unroll
                    for (int n = 0; n < 2; ++n) acc[a][b][m][n] = (f32x4){0.f, 0.f, 0.f, 0.f};
        cur = nxt; cA = nA; cB = nB; ++ui;
        if constexpr (ALIGN_EPI) { if (wr == 1) PG8_BAR; }
    }
    PG8_WAIT_V(0);
    if constexpr (!ALIGN_EPI) { if (wr == 0) PG8_BAR; }
    PG8_BAR;
    if constexpr (Epi::AFTER_DRAIN) { E.fused(acc, cur, wr, wc, fr, fq, lds, wid, lane); S.done(cur); }
#undef PG8_SA
#undef PG8_SB
#undef PG8_STAGE
#undef PG8_LDA
#undef PG8_LDB
#undef PG8_MMA
#undef PG8_WAIT_V
#undef PG8_WAIT_L
#undef PG8_BAR
#undef PG8_SCHED
}
}
#include <hip/hip_cooperative_groups.h>
namespace cg = cooperative_groups;
#define LAS __attribute__((address_space(3)))
typedef unsigned short bf16;
typedef float f32x4 __attribute__((ext_vector_type(4)));
typedef unsigned v4u __attribute__((ext_vector_type(4)));

constexpr int BATCH = 8, SEQ = 4096, DM = 1024, M = BATCH * SEQ, DFF = 2816, DIN = 2704, ZP = 2816, NGU = 2 * DFF, DEPTH = 2;
constexpr int NTHR = 512, NWAVES = 8;
constexpr int ZQ_FOX = 0, ZK_FOX = 256, ZV_FOX = 512, ZQ_NSA = 768, ZKC = 1024, ZVC = 1088, ZKS = 1152, ZVS = 1216, ZKW = 1280, ZVW = 1344,
              ZQ_SWA = 1408, ZK_SWA = 1664, ZV_SWA = 1792, ZQ_DIL = 1920, ZK_DIL = 2176, ZV_DIL = 2432, ZSMALL = 2688;
constexpr size_t MiB = 1u << 20;
constexpr size_t SZ_WGU = (size_t)NGU * DM * 2, SZ_WD = (size_t)DM * DFF * 2, SZ_WIN = (size_t)ZP * DM * 2, SZ_WOUT = (size_t)DM * DM * 2;
constexpr size_t OFF_WGU1 = 0, OFF_WD1 = OFF_WGU1 + SZ_WGU, OFF_WIN = OFF_WD1 + SZ_WD, OFF_WOUT = OFF_WIN + SZ_WIN, OFF_WGU2 = OFF_WOUT + SZ_WOUT, OFF_WD2 = OFF_WGU2 + SZ_WGU, LAYER_W = 43 * MiB;
static_assert(OFF_WD2 + SZ_WD <= LAYER_W, "weights per layer");
constexpr size_t WS_W = 0, WS_ZH = 86 * MiB, WS_XG = WS_ZH + 176 * MiB, WS_O = WS_XG + 64 * MiB, WS_DO = WS_O + 64 * MiB, WS_OC = WS_DO + 48 * MiB, WS_SM = WS_OC + 32 * MiB;
constexpr size_t WS_SSQ = WS_SM, WS_ZS = WS_SSQ + 2 * MiB, WS_CUM = WS_ZS + 2 * MiB, WS_KC = WS_CUM + 1 * MiB, WS_VC = WS_KC + 1 * MiB, WS_MASK = WS_VC + 1 * MiB, WS_DL = WS_MASK + 1 * MiB, WS_END = WS_DL + 2 * MiB;
static_assert((size_t)M * ZP * 2 <= 176 * MiB && WS_END <= 512 * MiB, "ws map");
constexpr size_t WS_W1T = WS_W + LAYER_W + OFF_WD2 + SZ_WD;
static_assert(OFF_WD2 + SZ_WD + 2 * MiB <= LAYER_W, "W1T fits behind layer 1's weights");
constexpr int LDS_BYTES = 147456;
#ifndef GSEL
#define GSEL 31
#endif
#ifndef REP_P4
#define REP_P4 1
#endif
#ifndef REP_P5
#define REP_P5 1
#endif
#ifndef REP_P6
#define REP_P6 1
#endif
#ifndef REP_G1
#define REP_G1 1
#endif


#ifndef REP_CPASS
#define REP_CPASS 1
#endif
#ifndef REP_CTOPK
#define REP_CTOPK 1
#endif
#ifndef REP_PRO
#define REP_PRO 1
#endif
#ifndef REP_FOX
#define REP_FOX 1
#endif
#ifndef REP_CMP
#define REP_CMP 1
#endif
#ifndef REP_DIL
#define REP_DIL 1
#endif
#ifndef FA_FOX
#define FA_FOX 1
#endif
#ifndef FA_CMP
#define FA_CMP 1
#endif
#ifndef FA_SWA
#define FA_SWA 1
#endif
#ifndef FA_DIL
#define FA_DIL 1
#endif
#ifndef FA_NSA
#define FA_NSA 1
#endif

struct Args { const float* in[18]; float* out; unsigned char* ws; };
typedef const __attribute__((address_space(4))) Args* CArgsP;

__device__ __forceinline__ unsigned f2bf(float f) { unsigned u = __builtin_bit_cast(unsigned, f); return (u + 0x7fffu + ((u >> 16) & 1u)) >> 16; }
__device__ __forceinline__ unsigned pk2(float lo, float hi) { return f2bf(lo) | (f2bf(hi) << 16); }
__device__ __forceinline__ float bflo(unsigned w) { return __uint_as_float(w << 16); }
__device__ __forceinline__ float bfhi(unsigned w) { return __uint_as_float(w & 0xffff0000u); }
__device__ __forceinline__ float wave_sum(float v) {
#pragma unroll
    for (int o = 1; o < 64; o <<= 1) v += __shfl_xor(v, o);
    return v;
}
__device__ __forceinline__ float sigmoidf_(float x) { return 1.0f / (1.0f + __expf(-x)); }

__device__ __forceinline__ void tr_item(const float* srcp, int N, int k0, bf16* dstblk, int K, LAS float* scr, int lane) {
    float v[32];
#pragma unroll
    for (int i = 0; i < 32; ++i) { const int kk = 2 * i + (lane >> 5); v[i] = srcp ? srcp[(size_t)(k0 + kk) * N] : 0.f; }
#pragma unroll
    for (int i = 0; i < 32; ++i) { const int kk = 2 * i + (lane >> 5); scr[kk * 33 + (lane & 31)] = v[i]; }
    asm volatile("s_waitcnt lgkmcnt(0)" ::: "memory");
    const int c = lane & 7;
#pragma unroll
    for (int j = 0; j < 4; ++j) { const int n = (lane >> 3) + 8 * j; const LAS float* s = scr + (8 * c) * 33 + n;
        v4u o; o.x = pk2(s[0 * 33], s[1 * 33]); o.y = pk2(s[2 * 33], s[3 * 33]); o.z = pk2(s[4 * 33], s[5 * 33]); o.w = pk2(s[6 * 33], s[7 * 33]);
        *(v4u*)(dstblk + (size_t)n * K + 8 * c) = o; }
    asm volatile("s_waitcnt lgkmcnt(0)" ::: "memory");
}
__device__ __forceinline__ int win_src_col(int r) {
    if (r < 768) return r;
    if (r < 1408) return r + 4;
    if (r < 2688) return r + 16;
    if (r < 2692) return 768 + (r - 2688);
    if (r < 2704) return 1412 + (r - 2692);
    return -1;
}
__device__ __forceinline__ void prologue(CArgsP a, LAS unsigned char* lds, int gw, int NGW, int wave, int lane) {
    LAS float* scr = (LAS float*)(lds + wave * 16384);
    constexpr int I_GU = (DM / 64) * (NGU / 32), I_D = (DFF / 64) * (DM / 32), I_IN = (DM / 64) * (ZP / 32), I_OUT = (DM / 64) * (DM / 32);
    constexpr int I_LAYER = 2 * I_GU + 2 * I_D + I_IN + I_OUT;
    for (int it = gw; it < DEPTH * I_LAYER; it += NGW) {
        const int l = it / I_LAYER; int r = it % I_LAYER;
        unsigned char* wl = a->ws + WS_W + (size_t)l * LAYER_W;
        if (r < 2 * I_GU) {
            const int f = r / I_GU; r %= I_GU; const int nblk = NGU / 32, kb = r / nblk, nb = r % nblk, d0 = nb * 32;
            const int tile = d0 / 256, within = d0 % 256; const bool up = within >= 128; const int c0 = tile * 128 + (within & 127);
            const float* W = a->in[f == 0 ? (up ? 3 : 2) : (up ? 15 : 14)] + (size_t)l * DM * DFF;
            bf16* WT = (bf16*)(wl + (f == 0 ? OFF_WGU1 : OFF_WGU2));
            tr_item(W + c0 + (lane & 31), DFF, kb * 64, WT + (size_t)d0 * DM + kb * 64, DM, scr, lane);
            continue;
        }
        r -= 2 * I_GU;
        if (r < 2 * I_D) {
            const int f = r / I_D; r %= I_D; const int nblk = DM / 32, kb = r / nblk, nb = r % nblk, d0 = nb * 32;
            const float* W = a->in[f == 0 ? 4 : 16] + (size_t)l * DFF * DM;
            bf16* WT = (bf16*)(wl + (f == 0 ? OFF_WD1 : OFF_WD2));
            tr_item(W + d0 + (lane & 31), DM, kb * 64, WT + (size_t)d0 * DFF + kb * 64, DFF, scr, lane);
            continue;
        }
        r -= 2 * I_D;
        if (r < I_IN) {
            const int nblk = ZP / 32, kb = r / nblk, nb = r % nblk, d0 = nb * 32;
            const int sc = win_src_col(d0 + (lane & 31));
            const float* W = a->in[6] + (size_t)l * DM * DIN;
            tr_item(sc >= 0 ? W + sc : nullptr, DIN, kb * 64, (bf16*)(wl + OFF_WIN) + (size_t)d0 * DM + kb * 64, DM, scr, lane);
            continue;
        }
        r -= I_IN;
        {
            const int nblk = DM / 32, kb = r / nblk, nb = r % nblk, d0 = nb * 32;
            const float* W = a->in[12] + (size_t)l * DM * DM;
            tr_item(W + d0 + (lane & 31), DM, kb * 64, (bf16*)(wl + OFF_WOUT) + (size_t)d0 * DM + kb * 64, DM, scr, lane);
        }
    }
    for (int it = gw; it < 4 * 128; it += NGW) {
        const int li = it >> 7, r = it & 127, kb = r >> 2, d0 = (r & 3) * 32;
        tr_item(a->in[9] + (size_t)li * 2048 * 128 + d0 + (lane & 31), 128, kb * 64, (bf16*)(a->ws + WS_W1T) + ((size_t)li * 128 + d0) * 2048 + kb * 64, 2048, scr, lane);
    }
    const float* x = a->in[0]; const float* g = a->in[1]; bf16* XG = (bf16*)(a->ws + WS_XG); float* SSQ = (float*)(a->ws + WS_SSQ);
    f32x4 gv[4];
#pragma unroll
    for (int j = 0; j < 4; ++j) gv[j] = *(const f32x4*)(g + 4 * lane + 256 * j);
    for (int m = gw; m < M; m += NGW) {
        const f32x4* xr = (const f32x4*)(x + (size_t)m * DM) + lane; float s = 0.f; f32x4 v[4];
#pragma unroll
        for (int j = 0; j < 4; ++j) { v[j] = xr[64 * j]; s += (v[j][0] * v[j][0] + v[j][1] * v[j][1]) + (v[j][2] * v[j][2] + v[j][3] * v[j][3]); }
        s = wave_sum(s);
        unsigned long long* o8 = (unsigned long long*)(XG + (size_t)m * DM) + lane;
#pragma unroll
        for (int j = 0; j < 4; ++j) { const f32x4 y = v[j] * gv[j]; o8[64 * j] = (unsigned long long)pk2(y[0], y[1]) | ((unsigned long long)pk2(y[2], y[3]) << 32); }
        if (lane < 16) SSQ[(size_t)m * 16 + lane] = lane == 0 ? s : 0.f;
    }
}

struct NAcc { float m, l; float o[32]; };
__device__ __forceinline__ void nacc_init(NAcc& a) { a.m = -INFINITY; a.l = 0.f;
#pragma unroll
    for (int d = 0; d < 32; ++d) a.o[d] = 0.f; }
__device__ __forceinline__ void load_q(unsigned (&q)[16], const bf16* p) {
    const v4u* p4 = (const v4u*)p;
#pragma unroll
    for (int i = 0; i < 4; ++i) { const v4u w = p4[i]; q[4 * i] = w.x; q[4 * i + 1] = w.y; q[4 * i + 2] = w.z; q[4 * i + 3] = w.w; }
}
__device__ __forceinline__ float dot32(const unsigned (&q)[16], const bf16* krow) {
    const v4u* p4 = (const v4u*)krow; float s0 = 0.f, s1 = 0.f;
#pragma unroll
    for (int i = 0; i < 4; ++i) { const v4u w = p4[i];
        s0 += bflo(q[4 * i]) * bflo(w.x); s1 += bfhi(q[4 * i]) * bfhi(w.x); s0 += bflo(q[4 * i + 1]) * bflo(w.y); s1 += bfhi(q[4 * i + 1]) * bfhi(w.y);
        s0 += bflo(q[4 * i + 2]) * bflo(w.z); s1 += bfhi(q[4 * i + 2]) * bfhi(w.z); s0 += bflo(q[4 * i + 3]) * bflo(w.w); s1 += bfhi(q[4 * i + 3]) * bfhi(w.w); }
    float s = s0 + s1; s += __shfl_xor(s, 1); return s;
}
__device__ __forceinline__ void axpy32(float (&o)[32], float p, const bf16* vrow) {
    const v4u* p4 = (const v4u*)vrow;
#pragma unroll
    for (int i = 0; i < 4; ++i) { const v4u w = p4[i];
        o[8 * i + 0] += p * bflo(w.x); o[8 * i + 1] += p * bfhi(w.x); o[8 * i + 2] += p * bflo(w.y); o[8 * i + 3] += p * bfhi(w.y);
        o[8 * i + 4] += p * bflo(w.z); o[8 * i + 5] += p * bfhi(w.z); o[8 * i + 6] += p * bflo(w.w); o[8 * i + 7] += p * bfhi(w.w); }
}
__device__ __forceinline__ void attend1(const unsigned (&q)[16], NAcc& a, const bf16* krow, const bf16* vrow, bool valid, float bias) {
    const float dq = dot32(q, krow);
    const float s = valid ? dq * 0.125f + bias : -INFINITY;
    asm volatile("" ::: "memory");
    const float mn = fmaxf(a.m, s);
    if (__any(valid)) {
        const float ms = (mn == -INFINITY) ? 0.f : mn;
        const float alpha = __expf(a.m - ms), p = __expf(s - ms);
        if (__any(mn > a.m)) {
#pragma unroll
            for (int d = 0; d < 32; ++d) a.o[d] *= alpha;
        }
        a.l = a.l * alpha + p; a.m = mn;
        axpy32(a.o, p, vrow);
    }
    asm volatile("" ::: "memory");
}
__device__ __forceinline__ void store_o_bf16(bf16* dst, const float (&o)[32], float sc) {
    v4u* p4 = (v4u*)dst;
#pragma unroll
    for (int i = 0; i < 4; ++i) { v4u w; w.x = pk2(o[8 * i] * sc, o[8 * i + 1] * sc); w.y = pk2(o[8 * i + 2] * sc, o[8 * i + 3] * sc);
        w.z = pk2(o[8 * i + 4] * sc, o[8 * i + 5] * sc); w.w = pk2(o[8 * i + 6] * sc, o[8 * i + 7] * sc); p4[i] = w; }
}
__device__ __forceinline__ float alibi_slope(int i) { return exp2f(-8.0f * (float)(i + 1) / 12.0f); }

__device__ __forceinline__ void banded(const unsigned (&q)[16], NAcc& a, const bf16* Kb, const bf16* Vb, size_t stride, int i0s, int qi, int maxd, float slope) {
    int klo = i0s - maxd; if (klo < 0) klo = 0; const int khi = i0s + 31;
#pragma unroll 1
    for (int k = klo; k <= khi; ++k) {
        const int dist = qi - k;
        attend1(q, a, Kb + (size_t)k * stride, Vb + (size_t)k * stride, dist >= 0 && dist <= maxd, -slope * (float)dist);
    }
}

__device__ __forceinline__ void p4_cumsum(CArgsP a, int l, LAS unsigned char* lds, int bh) {
    int tid = threadIdx.x; asm volatile("" : "+v"(tid)); const int b = bh >> 2, h = bh & 3;
    const float* ZS = (const float*)(a->ws + WS_ZS); float* CUM = (float*)(a->ws + WS_CUM);
    const float bf = a->in[7][l * 4 + h];
    LAS float* part = (LAS float*)lds;
    float v[8]; float s = 0.f;
#pragma unroll
    for (int i = 0; i < 8; ++i) { const int t = tid * 8 + i; const float x = ZS[(size_t)(b * SEQ + t) * 16 + h] + bf;
        const float ls = fminf(x, 0.f) - log1pf(__expf(-fabsf(x))); s += ls; v[i] = s; }
    float incl = s;
#pragma unroll
    for (int o = 1; o < 64; o <<= 1) { const float t = __shfl_up(incl, o); if ((tid & 63) >= o) incl += t; }
    if ((tid & 63) == 63) part[tid >> 6] = incl;
    __syncthreads();
    float woff = 0.f;
    for (int w = 0; w < (tid >> 6); ++w) woff += part[w];
    const float off = woff + incl - s;
#pragma unroll
    for (int i = 0; i < 8; ++i) { const float cv = v[i] + off; CUM[(size_t)bh * SEQ + tid * 8 + i] = cv;
        const float x = -8.0f * cv; const unsigned h1 = f2bf(x); const float r1 = x - __uint_as_float(h1 << 16); const unsigned h2 = f2bf(r1); const float r2 = r1 - __uint_as_float(h2 << 16); const unsigned h3 = f2bf(r2);
        *(v4u*)(a->ws + WS_W + OFF_WD2 + SZ_WD + ((size_t)bh * SEQ + tid * 8 + i) * 16) = (v4u){h1 | (h2 << 16), h3, 0u, 0u}; }
    __syncthreads();
}
__device__ __forceinline__ void p4_compress(CArgsP a, int l, LAS unsigned char* lds, int item) {
    typedef short bf16x8c __attribute__((ext_vector_type(8)));
    int tid = threadIdx.x; asm volatile("" : "+v"(tid)); const int g = item & 15, b = (item >> 4) & 7, idx = item >> 7;
    const int wave = tid >> 6, lane = tid & 63, n = lane & 15, q4 = lane >> 4;
    const bf16* Z = (const bf16*)(a->ws + WS_ZH);
    LAS bf16* xs = (LAS bf16*)lds;
    LAS float* hid = (LAS float*)(lds + 40960);
    const int n0 = g * 16, t0 = n0 * 16, col = idx == 0 ? ZKC : ZVC;
    for (int i = tid; i < 272 * 8; i += NTHR) { const int tt = i >> 3, ch = i & 7, t = t0 + tt;
        v4u v = (v4u){0u, 0u, 0u, 0u}; if (t < SEQ) v = *(const v4u*)(Z + (size_t)(b * SEQ + t) * ZP + col + ch * 8);
        *(LAS v4u*)(xs + ((tt & 15) * 17 + (tt >> 4)) * 72 + ch * 8) = v; }
    __syncthreads();
    const float* pe = a->in[8] + (size_t)(l * 2 + idx) * 32 * 64;
    const bf16* w1t = (const bf16*)(a->ws + WS_W1T) + ((size_t)(l * 2 + idx) * 128 + wave * 16 + n) * 2048;
    const float* w2 = a->in[10] + (size_t)(l * 2 + idx) * 128 * 64;
    f32x4 acc = (f32x4){0.f, 0.f, 0.f, 0.f};
#pragma unroll 4
    for (int ks = 0; ks < 64; ++ks) {
        const int ll = ks >> 1, d0 = (ks & 1) * 32 + 8 * q4;
        const v4u xa = *(const LAS v4u*)(xs + ((ll & 15) * 17 + n + (ll >> 4)) * 72 + d0);
        const f32x4 p0 = *(const f32x4*)(pe + ll * 64 + d0), p1 = *(const f32x4*)(pe + ll * 64 + d0 + 4);
        v4u am; am.x = pg8::cvt_pk_bf16(bflo(xa.x) + p0[0], bfhi(xa.x) + p0[1]); am.y = pg8::cvt_pk_bf16(bflo(xa.y) + p0[2], bfhi(xa.y) + p0[3]);
        am.z = pg8::cvt_pk_bf16(bflo(xa.z) + p1[0], bfhi(xa.z) + p1[1]); am.w = pg8::cvt_pk_bf16(bflo(xa.w) + p1[2], bfhi(xa.w) + p1[3]);
        const bf16x8c bm = *(const bf16x8c*)(w1t + ks * 32 + 8 * q4);
        acc = __builtin_amdgcn_mfma_f32_16x16x32_bf16(__builtin_bit_cast(bf16x8c, am), bm, acc, 0, 0, 0);
    }
#pragma unroll
    for (int j = 0; j < 4; ++j) { const float sv = acc[j]; hid[(4 * q4 + j) * 128 + wave * 16 + n] = sv * sigmoidf_(sv); }
    __syncthreads();
    bf16* KC = (bf16*)(a->ws + (idx == 0 ? WS_KC : WS_VC)); bf16* VCT = (bf16*)(a->ws + WS_VC + 512 * 1024);
    for (int o = tid; o < 16 * 64; o += NTHR) { const int i = o >> 6, e2 = o & 63; float sv = 0.f;
#pragma unroll 16
        for (int ee = 0; ee < 128; ++ee) sv += hid[i * 128 + ee] * w2[ee * 64 + e2];
        const int nn = n0 + i; const bf16 val = nn < 255 ? (bf16)f2bf(sv) : (bf16)0;
        const int T = nn >> 5, kk = nn & 31;
        if (idx == 0) KC[(size_t)b * 256 * 64 + ((T * 8 + (e2 >> 3)) * 32 + kk) * 8 + (e2 & 7)] = val;
        else { const int k16 = kk & 15; VCT[(size_t)b * 256 * 64 + (((((T * 2 + (e2 >> 5)) * 2 + (kk >> 4)) * 2 + ((k16 >> 2) & 1)) * 32 + (e2 & 31)) * 8) + (k16 & 3) + 4 * (k16 >> 3)] = val; } }
    __syncthreads();
}
__device__ __forceinline__ void p4_dil_item(CArgsP a, int it, int lane) {
    const int blk64 = it & 63, bh = (it >> 6) & 31, g = it >> 11; const int b = bh >> 2, h = bh & 3;
    const int dd = g == 0 ? 1 : (g == 1 ? 4 : 16); const int per = 64 / dd;
    const int r = blk64 / per, i0 = (blk64 % per) * 64; const int hoff = 32 * (lane & 1);
    const bf16* Z = (const bf16*)(a->ws + WS_ZH); const size_t rowb = (size_t)b * SEQ;
    bf16* DO = (bf16*)(a->ws + WS_DO); float* DL = (float*)(a->ws + WS_DL);
    for (int sub = 0; sub < 2; ++sub) {
        const int i0s = i0 + sub * 32, qi = i0s + (lane >> 1), t = r + dd * qi;
        unsigned q[16]; load_q(q, Z + (rowb + t) * ZP + ZQ_DIL + h * 64 + hoff);
        NAcc acc; nacc_init(acc);
        banded(q, acc, Z + (rowb + r) * ZP + ZK_DIL + h * 64 + hoff, Z + (rowb + r) * ZP + ZV_DIL + h * 64 + hoff, (size_t)dd * ZP, i0s, qi, 128, alibi_slope(8 + h) * (float)dd);
        store_o_bf16(DO + ((size_t)g * M + rowb + t) * 256 + h * 64 + hoff, acc.o, 1.0f / acc.l);
        if ((lane & 1) == 0) DL[((size_t)g * M + rowb + t) * 4 + h] = acc.m + __logf(acc.l);
    }
}
__device__ __forceinline__ void p4_swa_item(CArgsP a, int l, int it, int lane) {
    const int blk = it & 63, bh = it >> 6; const int b = bh >> 2, h = bh & 3, kvh = h >> 1; const int hoff = 32 * (lane & 1);
    const bf16* Z = (const bf16*)(a->ws + WS_ZH); const size_t rowb = (size_t)b * SEQ;
    const float sink = a->in[11][l * 4 + h];
    for (int sub = 0; sub < 2; ++sub) {
        const int i0s = blk * 64 + sub * 32, t = i0s + (lane >> 1);
        unsigned q[16]; load_q(q, Z + (rowb + t) * ZP + ZQ_SWA + h * 64 + hoff);
        NAcc acc; nacc_init(acc);
        banded(q, acc, Z + rowb * ZP + ZK_SWA + kvh * 64 + hoff, Z + rowb * ZP + ZV_SWA + kvh * 64 + hoff, (size_t)ZP, i0s, t, 127, alibi_slope(h));
        const float lse = acc.m + __logf(acc.l); const float keep = sigmoidf_(lse - sink);
        store_o_bf16((bf16*)(a->ws + WS_O) + (rowb + t) * DM + (8 + h) * 64 + hoff, acc.o, keep / acc.l);
    }
}
__device__ __forceinline__ void p5_fox_item(CArgsP a, int it, int lane) {
    const int bh = it & 31, blk = 63 - (it >> 5); const int b = bh >> 2, h = bh & 3; const int hoff = 32 * (lane & 1);
    const bf16* Z = (const bf16*)(a->ws + WS_ZH); const size_t rowb = (size_t)b * SEQ; const float* c = (const float*)(a->ws + WS_CUM) + (size_t)bh * SEQ;
    const bf16* Kb = Z + rowb * ZP + ZK_FOX + h * 64 + hoff; const bf16* Vb = Z + rowb * ZP + ZV_FOX + h * 64 + hoff;
    for (int sub = 0; sub < 2; ++sub) {
        const int t = blk * 64 + sub * 32 + (lane >> 1);
        unsigned q[16]; load_q(q, Z + (rowb + t) * ZP + ZQ_FOX + h * 64 + hoff);
        NAcc acc; nacc_init(acc); const float ct = c[t];
        const int khi = blk * 64 + sub * 32 + 31;
#pragma unroll 1
        for (int k = 0; k <= khi; ++k) attend1(q, acc, Kb + (size_t)k * ZP, Vb + (size_t)k * ZP, k <= t, ct - c[k]);
        store_o_bf16((bf16*)(a->ws + WS_O) + (rowb + t) * DM + h * 64 + hoff, acc.o, 1.0f / acc.l);
    }
}
__device__ __forceinline__ void p5_cmp_item(CArgsP a, int it, LAS float* imps  , int lane) {
    const int blk = it & 63, b = it >> 6; const size_t rowb = (size_t)b * SEQ; const int hoff = 32 * (lane & 1);
    const bf16* Z = (const bf16*)(a->ws + WS_ZH); const float* ZS = (const float*)(a->ws + WS_ZS);
    const bf16* KC = (const bf16*)(a->ws + WS_KC) + (size_t)b * 256 * 64 + hoff; const bf16* VC = (const bf16*)(a->ws + WS_VC) + (size_t)b * 256 * 64 + hoff;
    float* OC = (float*)(a->ws + WS_OC);
    for (int j = 0; j < 64; ++j) imps[lane * 65 + j] = 0.f;
    for (int sub = 0; sub < 2; ++sub) {
        const int tt = sub * 32 + (lane >> 1), t = blk * 64 + tt;
        const int tmax = blk * 64 + sub * 32 + 31; const int ncm = tmax >= 31 ? (tmax - 31) / 16 + 1 : 0;
        for (int h = 0; h < 4; ++h) {
            const float slope = alibi_slope(4 + h);
            unsigned q[16]; load_q(q, Z + (rowb + t) * ZP + ZQ_NSA + h * 64 + hoff);
            NAcc acc; nacc_init(acc);
#pragma unroll 1
            for (int n = 0; n < ncm; ++n) { const int dist = t - (16 * n + 31); attend1(q, acc, KC + n * 64, VC + n * 64, dist >= 0, -slope * (float)dist); }
            const float g0 = sigmoidf_(ZS[(rowb + t) * 16 + 4 + h * 3 + 0]);
            const float inv = 1.0f / fmaxf(acc.l, 1e-30f);
            { f32x4* o4 = (f32x4*)(OC + (rowb + t) * 256 + h * 64 + hoff); const float sc = inv * g0;
#pragma unroll
              for (int i = 0; i < 8; ++i) o4[i] = (f32x4){acc.o[4 * i] * sc, acc.o[4 * i + 1] * sc, acc.o[4 * i + 2] * sc, acc.o[4 * i + 3] * sc}; }
            const float ms = (acc.m == -INFINITY) ? 0.f : acc.m;
            float cur = 0.f; const bool wr = (lane & 1) == 0;
#pragma unroll 1
            for (int n = 0; n < ncm; ++n) {
                const int dist = t - (16 * n + 31);
                const float dq = dot32(q, KC + n * 64);
                const float s = dist >= 0 ? dq * 0.125f - slope * (float)dist : -INFINITY;
                const float p = __expf(s - ms) * inv;
                cur += p;
                if ((n & 3) == 3) { if (wr) imps[tt * 65 + (n >> 2)] += cur; cur = p; }
            }
            if (ncm > 0 && (ncm >> 2) < 64 && wr) imps[tt * 65 + (ncm >> 2)] += cur;
        }
    }
    unsigned long long mymask = 0ull;
    for (int tt = 0; tt < 64; ++tt) {
        const int curb = blk;
        const float imp = imps[tt * 65 + lane];
        const bool causal = lane <= curb; const bool forced = (lane == 0) || (lane == curb) || (lane == curb - 1);
        const float score = causal ? (forced ? INFINITY : imp) : -INFINITY;
        int rank = 0;
        for (int jj = 0; jj < 64; ++jj) { const float o = __shfl(score, jj); rank += (o > score || (o == score && jj < lane)) ? 1 : 0; }
        const unsigned long long mk = __ballot(rank < 16 && causal);
        if (lane == tt) mymask = mk;
    }
    ((unsigned long long*)(a->ws + WS_MASK))[rowb + blk * 64 + lane] = mymask;
}
__device__ __forceinline__ void p5_dilcomb_item(CArgsP a, int it, int lane_in) {
    int lane = lane_in; asm volatile("" : "+v"(lane));
    const int blk = it & 63, bh = it >> 6; const int b = bh >> 2, h = bh & 3; const size_t row = (size_t)b * SEQ + blk * 64 + lane;
    const bf16* DO = (const bf16*)(a->ws + WS_DO); const float* DL = (const float*)(a->ws + WS_DL);
    const float l0 = DL[row * 4 + h], l1 = DL[((size_t)M + row) * 4 + h], l2 = DL[((size_t)2 * M + row) * 4 + h];
    const float mx = fmaxf(l0, fmaxf(l1, l2)); float w0 = __expf(l0 - mx), w1 = __expf(l1 - mx), w2 = __expf(l2 - mx); const float inv = 1.0f / (w0 + w1 + w2); w0 *= inv; w1 *= inv; w2 *= inv;
    const v4u* p0 = (const v4u*)(DO + row * 256 + h * 64); const v4u* p1 = (const v4u*)(DO + ((size_t)M + row) * 256 + h * 64); const v4u* p2 = (const v4u*)(DO + ((size_t)2 * M + row) * 256 + h * 64);
    v4u* o4 = (v4u*)((bf16*)(a->ws + WS_O) + row * DM + (12 + h) * 64);
#pragma unroll 2
    for (int i = 0; i < 8; ++i) { const v4u x = p0[i], y = p1[i], z = p2[i]; v4u w;
        w.x = pk2(w0 * bflo(x.x) + w1 * bflo(y.x) + w2 * bflo(z.x), w0 * bfhi(x.x) + w1 * bfhi(y.x) + w2 * bfhi(z.x));
        w.y = pk2(w0 * bflo(x.y) + w1 * bflo(y.y) + w2 * bflo(z.y), w0 * bfhi(x.y) + w1 * bfhi(y.y) + w2 * bfhi(z.y));
        w.z = pk2(w0 * bflo(x.z) + w1 * bflo(y.z) + w2 * bflo(z.z), w0 * bfhi(x.z) + w1 * bfhi(y.z) + w2 * bfhi(z.z));
        w.w = pk2(w0 * bflo(x.w) + w1 * bflo(y.w) + w2 * bflo(z.w), w0 * bfhi(x.w) + w1 * bfhi(y.w) + w2 * bfhi(z.w));
        o4[i] = w; }
}
__device__ __forceinline__ void p6_nsa_item(CArgsP a, int it, int lane) {
    const int bh = it & 31, blk = 63 - (it >> 5); const int b = bh >> 2, h = bh & 3; const size_t rowb = (size_t)b * SEQ; const int hoff = 32 * (lane & 1);
    const bf16* Z = (const bf16*)(a->ws + WS_ZH); const float* ZS = (const float*)(a->ws + WS_ZS);
    const float slope = alibi_slope(4 + h);
    for (int sub = 0; sub < 2; ++sub) {
        const int i0s = blk * 64 + sub * 32, t = i0s + (lane >> 1);
        unsigned q[16]; load_q(q, Z + (rowb + t) * ZP + ZQ_NSA + h * 64 + hoff);
        const unsigned long long mask = ((const unsigned long long*)(a->ws + WS_MASK))[rowb + t];
        float* OC = (float*)(a->ws + WS_OC) + (rowb + t) * 256 + h * 64 + hoff;
        const float g1 = sigmoidf_(ZS[(rowb + t) * 16 + 4 + h * 3 + 1]), g2 = sigmoidf_(ZS[(rowb + t) * 16 + 4 + h * 3 + 2]);
        {
            NAcc acc; nacc_init(acc);
            const bf16* Kb = Z + rowb * ZP + ZKS + hoff; const bf16* Vb = Z + rowb * ZP + ZVS + hoff;
            for (int j = 0; j <= blk; ++j) {
                const bool sel = (mask >> j) & 1ull;
                if (!__any(sel)) continue;
#pragma unroll 1
                for (int k = j * 64; k < j * 64 + 64; ++k) attend1(q, acc, Kb + (size_t)k * ZP, Vb + (size_t)k * ZP, sel && k <= t, -slope * (float)(t - k));
            }
            const float sc = g1 / fmaxf(acc.l, 1e-30f);
            f32x4* o4 = (f32x4*)OC;
#pragma unroll
            for (int i = 0; i < 8; ++i) { f32x4 v = o4[i]; v[0] += acc.o[4 * i] * sc; v[1] += acc.o[4 * i + 1] * sc; v[2] += acc.o[4 * i + 2] * sc; v[3] += acc.o[4 * i + 3] * sc; o4[i] = v; }
        }
        asm volatile("" ::: "memory");
        {
            NAcc acc; nacc_init(acc);
            banded(q, acc, Z + rowb * ZP + ZKW + hoff, Z + rowb * ZP + ZVW + hoff, (size_t)ZP, i0s, t, 511, slope);
            const float sc = g2 / acc.l;
            const f32x4* o4 = (const f32x4*)OC; v4u* d4 = (v4u*)((bf16*)(a->ws + WS_O) + (rowb + t) * DM + (4 + h) * 64 + hoff);
#pragma unroll
            for (int i = 0; i < 4; ++i) { const f32x4 x = o4[2 * i], y = o4[2 * i + 1]; v4u w;
                w.x = pk2(x[0] + acc.o[8 * i] * sc, x[1] + acc.o[8 * i + 1] * sc); w.y = pk2(x[2] + acc.o[8 * i + 2] * sc, x[3] + acc.o[8 * i + 3] * sc);
                w.z = pk2(y[0] + acc.o[8 * i + 4] * sc, y[1] + acc.o[8 * i + 5] * sc); w.w = pk2(y[2] + acc.o[8 * i + 6] * sc, y[3] + acc.o[8 * i + 7] * sc); d4[i] = w; }
        }
    }
}

typedef short bf16x8 __attribute__((ext_vector_type(8)));
typedef float f32x16 __attribute__((ext_vector_type(16)));
typedef unsigned u32x2_t __attribute__((ext_vector_type(2)));
constexpr float LOG2E = 1.4426950408889634f, C2S = 0.125f * 1.4426950408889634f, LN2F = 0.6931471805599453f;
constexpr size_t WS_VT_SWA = 504 * MiB;
constexpr size_t WS_KF_FOX = WS_OC, WS_VF_FOX = WS_OC + 16 * MiB;
constexpr size_t WS_KF_NS = 480 * MiB, WS_VF_NS = 484 * MiB, WS_KF_NW = 488 * MiB, WS_VF_NW = 492 * MiB;
constexpr size_t WS_OCB = WS_XG + 48 * MiB;
constexpr size_t WS_VT_DIL = WS_XG;
constexpr size_t WS_VCT = WS_VC + 512 * 1024;
constexpr size_t WS_CKA = WS_W + OFF_WD2 + SZ_WD;
static_assert(OFF_WD2 + SZ_WD + 2 * MiB <= LAYER_W, "CKA fits behind layer 0's weights");
static_assert(WS_END <= 480 * MiB, "small region vs V^T buffers");

__device__ __forceinline__ int crow(int r, int hi) { return (r & 3) + 8 * (r >> 2) + 4 * hi; }
struct FA { f32x16 o0, o1; float m, l; };
__device__ __forceinline__ void fa_init(FA& s) { s.m = -INFINITY; s.l = 0.f;
#pragma unroll
    for (int r = 0; r < 16; ++r) { s.o0[r] = 0.f; s.o1[r] = 0.f; } }
__device__ __forceinline__ void load_frag4(bf16x8 (&f)[4], const bf16* row, int hi) {
#pragma unroll
    for (int d0 = 0; d0 < 4; ++d0) f[d0] = *(const bf16x8*)(row + d0 * 16 + hi * 8);
}
__device__ __forceinline__ void load_vfrag(bf16x8 (&vf)[2][2], const bf16* vt, size_t vstride) {
#pragma unroll
    for (int dh = 0; dh < 2; ++dh)
#pragma unroll
        for (int i = 0; i < 2; ++i) { const bf16* p = vt + (size_t)dh * 32 * vstride + 16 * i;
            const u32x2_t a = *(const u32x2_t*)p, b = *(const u32x2_t*)(p + 8); vf[dh][i] = __builtin_bit_cast(bf16x8, (v4u){a.x, a.y, b.x, b.y}); }
}
__device__ __forceinline__ f32x16 qk_tile(const bf16x8 (&kf)[4], const bf16x8 (&qf)[4]) {
    f32x16 s;
#pragma unroll
    for (int r = 0; r < 16; ++r) s[r] = 0.f;
#pragma unroll
    for (int d0 = 0; d0 < 4; ++d0) s = __builtin_amdgcn_mfma_f32_32x32x16_bf16(kf[d0], qf[d0], s, 0, 0, 0);
    return s;
}
__device__ __forceinline__ void fa_softmax_pv(FA& st, f32x16& s, const bf16x8 (&vf)[2][2]) {
    float tmax = s[0];
#pragma unroll
    for (int r = 1; r < 16; ++r) tmax = fmaxf(tmax, s[r]);
    tmax = fmaxf(tmax, __shfl_xor(tmax, 32));
    const float mn = fmaxf(st.m, tmax);
    if (__any(mn > st.m)) {
        const float ms0 = (mn == -INFINITY) ? 0.f : mn;
        const float alpha = __builtin_amdgcn_exp2f(st.m - ms0);
        st.l *= alpha;
#pragma unroll
        for (int r = 0; r < 16; ++r) { st.o0[r] *= alpha; st.o1[r] *= alpha; }
        st.m = mn;
    }
    const float ms = (st.m == -INFINITY) ? 0.f : st.m;
    float ps = 0.f;
#pragma unroll
    for (int r = 0; r < 16; ++r) { s[r] = __builtin_amdgcn_exp2f(s[r] - ms); ps += s[r]; }
    st.l += ps;
    unsigned pk[8];
#pragma unroll
    for (int j = 0; j < 8; ++j) pk[j] = pg8::cvt_pk_bf16(s[2 * j], s[2 * j + 1]);
#pragma unroll
    for (int i = 0; i < 2; ++i) { const bf16x8 pb = __builtin_bit_cast(bf16x8, (v4u){pk[4 * i], pk[4 * i + 1], pk[4 * i + 2], pk[4 * i + 3]});
        st.o0 = __builtin_amdgcn_mfma_f32_32x32x16_bf16(vf[0][i], pb, st.o0, 0, 0, 0);
        st.o1 = __builtin_amdgcn_mfma_f32_32x32x16_bf16(vf[1][i], pb, st.o1, 0, 0, 0); }
}
struct FTile { bf16x8 k[4]; bf16x8 ka; };
struct VTile { bf16x8 v[2][2]; };
struct RangeIt { int tlo, thi, tfull;
    __device__ __forceinline__ int first() const { return tlo <= thi ? tlo : -1; }
    __device__ __forceinline__ int next(int t) const { return t < thi ? t + 1 : -1; }
    __device__ __forceinline__ bool masked(int t) const { return t < tfull || t == thi; }
    __device__ __forceinline__ bool block_ok(int t) const { return t >= tfull && t + 5 < thi; }
    __device__ __forceinline__ int clampt(int t) const { return t < thi ? t : thi; } };
template <bool CK, bool FRAG, bool VFRAG, class F, class It> __device__ __forceinline__ void fa_stream(FA& st, const bf16x8 (&qf)[4], const bf16* Kb, size_t kstride, const bf16* vtl, size_t vstride, const bf16* cka, const It& it, int r32, int hi, F f) {
    int ta = it.first(); if (ta < 0) return;
    int tb = it.next(ta), tc = tb >= 0 ? it.next(tb) : -1;
    FTile T0, T1, T2; VTile V0, V1;
    bf16x8 qa;
#pragma unroll
    for (int j = 0; j < 8; ++j) qa[j] = (short)((hi == 0 && j < 3) ? 0x3F80 : 0);
#define FA_LOAD(T, t_) do { if (FRAG) { _Pragma("unroll") for (int d0_ = 0; d0_ < 4; ++d0_) T.k[d0_] = *(const bf16x8*)(Kb + (size_t)(t_) * 2048 + ((d0_ * 2 + hi) * 32 + r32) * 8); } \
        else load_frag4(T.k, Kb + (size_t)((t_) * 32 + r32) * kstride, hi); \
        if (CK) { T.ka = *(const bf16x8*)(cka + (size_t)((t_) * 32 + r32) * 8); } } while (0)
#define FA_LOADV(V, t_) do { if (VFRAG) { _Pragma("unroll") for (int u_ = 0; u_ < 4; ++u_) V.v[u_ >> 1][u_ & 1] = *(const bf16x8*)(vtl + (size_t)(t_) * 2048 + ((u_ * 2 + hi) * 32 + r32) * 8); } \
        else load_vfrag(V.v, vtl + (t_) * 32, vstride); } while (0)
#define FA_STEP(T, V, t_) do { f32x16 s_ = qk_tile(T.k, qf); const int k0_ = (t_) * 32; \
        if (CK) { bf16x8 ka_ = T.ka; if (hi) { _Pragma("unroll") for (int j = 0; j < 8; ++j) ka_[j] = 0; } s_ = __builtin_amdgcn_mfma_f32_32x32x16_bf16(ka_, qa, s_, 0, 0, 0); } \
        f.begin_tile(k0_); if (f.tile_masked(it.masked(t_))) { _Pragma("unroll") for (int r = 0; r < 16; ++r) { const int key_ = k0_ + crow(r, hi); s_[r] = f.valid(key_) ? f.plain(key_, s_[r]) : -INFINITY; } } \
        else { _Pragma("unroll") for (int r = 0; r < 16; ++r) s_[r] = f.plain(k0_ + crow(r, hi), s_[r]); } \
        fa_softmax_pv(st, s_, V.v); } while (0)
    const int tsafe = ta;
#define CL(t_) ((t_) >= 0 ? (t_) : tsafe)
    FA_LOADV(V0, ta); FA_LOAD(T0, ta); FA_LOAD(T1, CL(tb));
#define FA_STEP_U(T, V, t_) do { f32x16 s_ = qk_tile(T.k, qf); const int k0_ = (t_) * 32; \
        if (CK) { bf16x8 ka_ = T.ka; if (hi) { _Pragma("unroll") for (int j = 0; j < 8; ++j) ka_[j] = 0; } s_ = __builtin_amdgcn_mfma_f32_32x32x16_bf16(ka_, qa, s_, 0, 0, 0); } \
        f.begin_tile(k0_); _Pragma("unroll") for (int r = 0; r < 16; ++r) s_[r] = f.plain(k0_ + crow(r, hi), s_[r]); \
        fa_softmax_pv(st, s_, V.v); } while (0)
#pragma unroll 1
    while (it.block_ok(ta)) {
        FA_LOADV(V1, ta + 1); FA_LOAD(T2, ta + 2); FA_STEP_U(T0, V0, ta);
        FA_LOADV(V0, ta + 2); FA_LOAD(T0, ta + 3); FA_STEP_U(T1, V1, ta + 1);
        FA_LOADV(V1, ta + 3); FA_LOAD(T1, ta + 4); FA_STEP_U(T2, V0, ta + 2);
        FA_LOADV(V0, ta + 4); FA_LOAD(T2, ta + 5); FA_STEP_U(T0, V1, ta + 3);
        FA_LOADV(V1, ta + 5); FA_LOAD(T0, it.clampt(ta + 6)); FA_STEP_U(T1, V0, ta + 4);
        FA_LOADV(V0, it.clampt(ta + 6)); FA_LOAD(T1, it.clampt(ta + 7)); FA_STEP_U(T2, V1, ta + 5);
        ta += 6;
    }
    tb = it.next(ta); tc = tb >= 0 ? it.next(tb) : -1;
#undef FA_STEP_U
#pragma unroll 1
    for (;;) {
        FA_LOADV(V1, CL(tb)); FA_LOAD(T2, CL(tc));
        FA_STEP(T0, V0, ta); if (tb < 0) break; ta = tc >= 0 ? it.next(tc) : -1;
        FA_LOADV(V0, CL(tc)); FA_LOAD(T0, CL(ta));
        FA_STEP(T1, V1, tb); if (tc < 0) break; tb = ta >= 0 ? it.next(ta) : -1;
        FA_LOADV(V1, CL(ta)); FA_LOAD(T1, CL(tb));
        FA_STEP(T2, V0, tc); if (ta < 0) break; tc = tb >= 0 ? it.next(tb) : -1;
        FA_LOADV(V0, CL(tb)); FA_LOAD(T2, CL(tc));
        FA_STEP(T0, V1, ta); if (tb < 0) break; ta = tc >= 0 ? it.next(tc) : -1;
        FA_LOADV(V1, CL(tc)); FA_LOAD(T0, CL(ta));
        FA_STEP(T1, V0, tb); if (tc < 0) break; tb = ta >= 0 ? it.next(ta) : -1;
        FA_LOADV(V0, CL(ta)); FA_LOAD(T1, CL(tb));
        FA_STEP(T2, V1, tc); if (ta < 0) break; tc = tb >= 0 ? it.next(tb) : -1;
    }
#undef CL
#undef FA_LOADV
#undef FA_LOAD
#undef FA_STEP
}
__device__ __forceinline__ void store_ot_bf16(bf16* orow, const f32x16& o0, const f32x16& o1, float sc, int hi) {
#pragma unroll
    for (int a4 = 0; a4 < 4; ++a4) {
        u32x2_t w0, w1;
        w0.x = pg8::cvt_pk_bf16(o0[4 * a4] * sc, o0[4 * a4 + 1] * sc); w0.y = pg8::cvt_pk_bf16(o0[4 * a4 + 2] * sc, o0[4 * a4 + 3] * sc);
        w1.x = pg8::cvt_pk_bf16(o1[4 * a4] * sc, o1[4 * a4 + 1] * sc); w1.y = pg8::cvt_pk_bf16(o1[4 * a4 + 2] * sc, o1[4 * a4 + 3] * sc);
        *(u32x2_t*)(orow + 8 * a4 + 4 * hi) = w0; *(u32x2_t*)(orow + 32 + 8 * a4 + 4 * hi) = w1;
    }
}
struct BandF { int qi, maxd; float slope2;
    __device__ __forceinline__ void begin_tile(int) {}
    __device__ __forceinline__ bool tile_masked(bool m) const { return m; }
    __device__ __forceinline__ float plain(int key, float raw) const { return raw * C2S - slope2 * (float)(qi - key); }
    __device__ __forceinline__ bool valid(int key) const { const int dist = qi - key; return dist >= 0 && dist <= maxd; } };
__device__ __forceinline__ int band_tfull(int i0, int maxd) { const int x = i0 + 31 - maxd; return x <= 0 ? 0 : (x + 31) >> 5; }

__device__ __forceinline__ void p4_vt_item(CArgsP a, int it, LAS unsigned short* scr  , int lane_in) {
    int lane = lane_in; asm volatile("" : "+v"(lane));
    const int ct = 6 + it % 6, tt = it / 6; const int b = tt >> 6, t0 = (tt & 63) * 64;
    const int scol = ct < 4 ? ZV_FOX + ct * 64 : (ct == 4 ? ZVS : (ct == 5 ? ZVW : (ct < 8 ? ZV_SWA + (ct - 6) * 64 : ZV_DIL + (ct - 8) * 64)));
    const bf16* Z = (const bf16*)(a->ws + WS_ZH);
    { const v4u* src = (const v4u*)(Z + ((size_t)b * SEQ + t0 + lane) * ZP + scol);
#pragma unroll
      for (int i = 0; i < 8; ++i) { const v4u w = src[i]; LAS unsigned* d = (LAS unsigned*)(scr + lane * 66 + 8 * i); d[0] = w.x; d[1] = w.y; d[2] = w.z; d[3] = w.w; } }
    asm volatile("s_waitcnt lgkmcnt(0)" ::: "memory");
    unsigned v[64];
#pragma unroll
    for (int t = 0; t < 64; ++t) v[t] = scr[t * 66 + lane];
    asm volatile("s_waitcnt lgkmcnt(0)" ::: "memory");
    if (ct < 8) {
        bf16* dst = (bf16*)(a->ws + WS_VT_SWA);
        const int ncol = 128; const int c = (ct - 6) * 64 + lane;
        v4u* o = (v4u*)(dst + ((size_t)b * ncol + c) * SEQ + t0);
#pragma unroll
        for (int i = 0; i < 8; ++i) o[i] = (v4u){v[8 * i] | (v[8 * i + 1] << 16), v[8 * i + 2] | (v[8 * i + 3] << 16), v[8 * i + 4] | (v[8 * i + 5] << 16), v[8 * i + 6] | (v[8 * i + 7] << 16)};
    } else {
        const int c = (ct - 8) * 64 + lane; bf16* base = (bf16*)(a->ws + WS_VT_DIL) + ((size_t)b * 256 + c) * SEQ;
        { v4u* o = (v4u*)(base + t0);
#pragma unroll
          for (int i = 0; i < 8; ++i) o[i] = (v4u){v[8 * i] | (v[8 * i + 1] << 16), v[8 * i + 2] | (v[8 * i + 3] << 16), v[8 * i + 4] | (v[8 * i + 5] << 16), v[8 * i + 6] | (v[8 * i + 7] << 16)}; }
        { bf16* b1 = base + (size_t)BATCH * 256 * SEQ;
#pragma unroll
          for (int r = 0; r < 4; ++r) { v4u* o = (v4u*)(b1 + r * (SEQ / 4) + t0 / 4);
#pragma unroll
              for (int i = 0; i < 2; ++i) o[i] = (v4u){v[4 * (8 * i) + r] | (v[4 * (8 * i + 1) + r] << 16), v[4 * (8 * i + 2) + r] | (v[4 * (8 * i + 3) + r] << 16),
                                                       v[4 * (8 * i + 4) + r] | (v[4 * (8 * i + 5) + r] << 16), v[4 * (8 * i + 6) + r] | (v[4 * (8 * i + 7) + r] << 16)}; } }
        { bf16* b2 = base + (size_t)2 * BATCH * 256 * SEQ;
#pragma unroll
          for (int r = 0; r < 16; ++r) { u32x2_t w; w.x = v[r] | (v[16 + r] << 16); w.y = v[32 + r] | (v[48 + r] << 16); *(u32x2_t*)(b2 + r * (SEQ / 16) + t0 / 16) = w; } }
    }
}

__device__ __forceinline__ void p4_kfrag_item(CArgsP a, int it, int lane_in) {
    int lane = lane_in; asm volatile("" : "+v"(lane));
    const int slot = 4 + (it & 1), tt = it >> 1; const int b = tt >> 7, T = tt & 127, r32 = lane & 31, hi = lane >> 5;
    const int col = slot == 4 ? ZKS : ZKW;
    const bf16* src = (const bf16*)(a->ws + WS_ZH) + ((size_t)b * SEQ + T * 32 + r32) * ZP + col + hi * 8;
    bf16* dst = (bf16*)(a->ws + (slot < 4 ? WS_KF_FOX : (slot == 4 ? WS_KF_NS : WS_KF_NW))) + ((size_t)(slot < 4 ? b * 4 + slot : b) * 128 + T) * 2048 + (hi * 32 + r32) * 8;
#pragma unroll
    for (int d0 = 0; d0 < 4; ++d0) *(v4u*)(dst + d0 * 512) = *(const v4u*)(src + d0 * 16);
}
__device__ __forceinline__ void p4_vfrag_item(CArgsP a, int it, LAS unsigned short* scr  , int lane_in) {
    int lane = lane_in; asm volatile("" : "+v"(lane));
    const int slot = it % 6, tt = it / 6; const int b = tt >> 7, T = tt & 127, r32 = lane & 31, hi = lane >> 5;
    const int col = slot < 4 ? ZV_FOX + slot * 64 : (slot == 4 ? ZVS : ZVW);
    { const v4u* src = (const v4u*)((const bf16*)(a->ws + WS_ZH) + ((size_t)b * SEQ + T * 32 + r32) * ZP + col + hi * 32);
#pragma unroll
      for (int i = 0; i < 4; ++i) { const v4u w = src[i]; LAS unsigned* d = (LAS unsigned*)(scr + r32 * 66 + hi * 32 + 8 * i); d[0] = w.x; d[1] = w.y; d[2] = w.z; d[3] = w.w; } }
    asm volatile("s_waitcnt lgkmcnt(0)" ::: "memory");
    bf16* dst = (bf16*)(a->ws + (slot < 4 ? WS_VF_FOX : (slot == 4 ? WS_VF_NS : WS_VF_NW))) + ((size_t)(slot < 4 ? b * 4 + slot : b) * 128 + T) * 2048 + (hi * 32 + r32) * 8;
#pragma unroll
    for (int dh = 0; dh < 2; ++dh)
#pragma unroll
        for (int i = 0; i < 2; ++i) { unsigned v[8];
#pragma unroll
            for (int j = 0; j < 8; ++j) v[j] = scr[(16 * i + 4 * hi + (j & 3) + 8 * (j >> 2)) * 66 + dh * 32 + r32];
            *(v4u*)(dst + (dh * 2 + i) * 512) = (v4u){v[0] | (v[1] << 16), v[2] | (v[3] << 16), v[4] | (v[5] << 16), v[6] | (v[7] << 16)}; }
    asm volatile("s_waitcnt lgkmcnt(0)" ::: "memory");
}

__device__ __forceinline__ void p4_vfrag2_item(CArgsP a, int it, LAS unsigned short* scr  , int lane_in) {
    int lane = lane_in; asm volatile("" : "+v"(lane));
    const int T = it & 127, b = (it >> 7) & 7, slot = it >> 10, r32 = lane & 31, hi = lane >> 5;
    int col, dd, sl; bf16* dst;
    if (slot < 2) { col = ZV_SWA + slot * 64; dd = 1; sl = SEQ; dst = (bf16*)(a->ws + WS_VT_SWA) + ((size_t)(b * 2 + slot) * 128 + T) * 2048; }
    else { const int g = (slot - 2) >> 2, h = (slot - 2) & 3; col = ZV_DIL + h * 64; dd = g == 0 ? 1 : (g == 1 ? 4 : 16); sl = SEQ / dd; dst = (bf16*)(a->ws + WS_VT_DIL) + ((size_t)(g * 32 + b * 4 + h) * 128 + T) * 2048; }
    const int p = T * 32 + r32, r = p / sl, j = p % sl, tok = r + dd * j;
    { const v4u* src = (const v4u*)((const bf16*)(a->ws + WS_ZH) + ((size_t)b * SEQ + tok) * ZP + col + hi * 32);
#pragma unroll
      for (int i = 0; i < 4; ++i) { const v4u w = src[i]; LAS unsigned* d = (LAS unsigned*)(scr + r32 * 66 + hi * 32 + 8 * i); d[0] = w.x; d[1] = w.y; d[2] = w.z; d[3] = w.w; } }
    asm volatile("s_waitcnt lgkmcnt(0)" ::: "memory");
    dst += (hi * 32 + r32) * 8;
#pragma unroll
    for (int dh = 0; dh < 2; ++dh)
#pragma unroll
        for (int i = 0; i < 2; ++i) { unsigned v[8];
#pragma unroll
            for (int jj = 0; jj < 8; ++jj) v[jj] = scr[(16 * i + 4 * hi + (jj & 3) + 8 * (jj >> 2)) * 66 + dh * 32 + r32];
            *(v4u*)(dst + (dh * 2 + i) * 512) = (v4u){v[0] | (v[1] << 16), v[2] | (v[3] << 16), v[4] | (v[5] << 16), v[6] | (v[7] << 16)}; }
    asm volatile("s_waitcnt lgkmcnt(0)" ::: "memory");
}

struct FoxF { int tq; float cq2;
    __device__ __forceinline__ void begin_tile(int) {}
    __device__ __forceinline__ bool tile_masked(bool m) const { return m; }
    __device__ __forceinline__ float plain(int, float raw) const { return raw * C2S + cq2; }
    __device__ __forceinline__ bool valid(int key) const { return key <= tq; } };
__device__ __forceinline__ void fa_fox_item(CArgsP a, int bh, int qt, int lane_in) {
    int lane = lane_in; asm volatile("" : "+v"(lane));
    const int b = bh >> 2, h = bh & 3, r32 = lane & 31, hi = lane >> 5; const int tq = qt * 32 + r32; const size_t rowb = (size_t)b * SEQ;
    const bf16* Z = (const bf16*)(a->ws + WS_ZH); const float* c = (const float*)(a->ws + WS_CUM) + (size_t)bh * SEQ;
    bf16x8 qf[4]; load_frag4(qf, Z + (rowb + tq) * ZP + ZQ_FOX + h * 64, hi);
    FA st; fa_init(st);
    const bf16* vtl = (const bf16*)(a->ws + WS_VF_FOX) + (size_t)bh * 128 * 2048;
    fa_stream<true, true, true>(st, qf, (const bf16*)(a->ws + WS_KF_FOX) + (size_t)bh * 128 * 2048, (size_t)ZP, vtl, (size_t)SEQ, (const bf16*)(a->ws + WS_CKA) + (size_t)bh * SEQ * 8, RangeIt{0, qt, 0}, r32, hi, FoxF{tq, c[tq] * LOG2E});
    const float l = st.l + __shfl_xor(st.l, 32);
    store_ot_bf16((bf16*)(a->ws + WS_O) + (rowb + tq) * DM + h * 64, st.o0, st.o1, 1.0f / l, hi);
}
__device__ __forceinline__ void fa_swa_item(CArgsP a, int l_, int it, int lane_in) {
    int lane = lane_in; asm volatile("" : "+v"(lane));
    const int qt = it & 127, bh = it >> 7; const int b = bh >> 2, h = bh & 3, kvh = h >> 1, r32 = lane & 31, hi = lane >> 5; const int tq = qt * 32 + r32; const size_t rowb = (size_t)b * SEQ;
    const bf16* Z = (const bf16*)(a->ws + WS_ZH);
    bf16x8 qf[4]; load_frag4(qf, Z + (rowb + tq) * ZP + ZQ_SWA + h * 64, hi);
    FA st; fa_init(st);
    const bf16* vtl = (const bf16*)(a->ws + WS_VT_SWA) + (size_t)(b * 2 + kvh) * 128 * 2048;
    int tlo = (qt * 32 - 127); tlo = tlo < 0 ? 0 : tlo >> 5;
    fa_stream<false, false, true>(st, qf, Z + rowb * ZP + ZK_SWA + kvh * 64, (size_t)ZP, vtl, (size_t)SEQ, nullptr, RangeIt{tlo, qt, band_tfull(qt * 32, 127)}, r32, hi, BandF{tq, 127, alibi_slope(h) * LOG2E});
    const float l = st.l + __shfl_xor(st.l, 32);
    const float lse = (st.m + __log2f(l)) * LN2F; const float keep = sigmoidf_(lse - a->in[11][l_ * 4 + h]);
    store_ot_bf16((bf16*)(a->ws + WS_O) + (rowb + tq) * DM + (8 + h) * 64, st.o0, st.o1, keep / l, hi);
}
__device__ __forceinline__ void fa_dil_item(CArgsP a, int it, int lane_in) {
    int lane = lane_in; asm volatile("" : "+v"(lane));
    const int pt = it & 127, bh = (it >> 7) & 31, g = it >> 12; const int b = bh >> 2, h = bh & 3, r32 = lane & 31, hi = lane >> 5; const size_t rowb = (size_t)b * SEQ;
    const int dd = g == 0 ? 1 : (g == 1 ? 4 : 16); const int sl = SEQ / dd;
    const int p0 = pt * 32; const int r = p0 / sl, j0 = p0 % sl; const int qt = j0 >> 5; const int qi = j0 + r32; const int t = r + dd * qi;
    const bf16* Z = (const bf16*)(a->ws + WS_ZH);
    bf16x8 qf[4]; load_frag4(qf, Z + (rowb + t) * ZP + ZQ_DIL + h * 64, hi);
    FA st; fa_init(st);
    const bf16* vtl = (const bf16*)(a->ws + WS_VT_DIL) + ((size_t)(g * 32 + bh) * 128 + (r * sl) / 32) * 2048;
    int tlo = j0 - 128; tlo = tlo < 0 ? 0 : tlo >> 5;
    fa_stream<false, false, true>(st, qf, Z + (rowb + r) * ZP + ZK_DIL + h * 64, (size_t)dd * ZP, vtl, (size_t)SEQ, nullptr, RangeIt{tlo, qt, band_tfull(j0, 128)}, r32, hi, BandF{qi, 128, alibi_slope(8 + h) * (float)dd * LOG2E});
    const float l = st.l + __shfl_xor(st.l, 32);
    store_ot_bf16((bf16*)(a->ws + WS_DO) + ((size_t)g * M + rowb + t) * 256 + h * 64, st.o0, st.o1, 1.0f / l, hi);
    if (hi == 0) ((float*)(a->ws + WS_DL))[((size_t)g * M + rowb + t) * 4 + h] = (st.m + __log2f(l)) * LN2F;
}
__device__ __forceinline__ void fa_cmp_passes(CArgsP a, int b, int qt, int h0, int h1, LAS float* imps  , int lane_in) {
    int lane = lane_in; asm volatile("" : "+v"(lane));
    for (int j = lane; j < 32 * 65; j += 64) imps[j] = 0.f;
    const int r32 = lane & 31, hi = lane >> 5; const int tq = qt * 32 + r32; const size_t rowb = (size_t)b * SEQ;
    const bf16* Z = (const bf16*)(a->ws + WS_ZH); const float* ZS = (const float*)(a->ws + WS_ZS);
    const bf16* KC = (const bf16*)(a->ws + WS_KC) + (size_t)b * 256 * 64; const bf16* VCF = (const bf16*)(a->ws + WS_VCT) + (size_t)b * 256 * 64;
    const int tmax = qt * 32 + 31; const int ncm = tmax >= 31 ? (tmax - 31) / 16 + 1 : 0; const int nt = (ncm + 31) >> 5;
    for (int h = h0; h < h1; ++h) {
        const float slope2 = alibi_slope(4 + h) * LOG2E;
        bf16x8 qf[4]; load_frag4(qf, Z + (rowb + tq) * ZP + ZQ_NSA + h * 64, hi);
        float m = -INFINITY, l = 0.f;
        bf16x8 kA[4], kB[4]; bf16x8 vA[2][2], vB[2][2];
#define CMP_LOADK(K_, t_) do { _Pragma("unroll") for (int d0_ = 0; d0_ < 4; ++d0_) K_[d0_] = *(const bf16x8*)(KC + (size_t)(t_) * 2048 + ((d0_ * 2 + hi) * 32 + r32) * 8); } while (0)
#define CMP_LOADV(V_, t_) do { _Pragma("unroll") for (int u_ = 0; u_ < 4; ++u_) V_[u_ >> 1][u_ & 1] = *(const bf16x8*)(VCF + (size_t)(t_) * 2048 + ((u_ * 2 + hi) * 32 + r32) * 8); } while (0)
#define CMP_P1(K_, t_) do { f32x16 s = qk_tile(K_, qf); float tm = -INFINITY; \
            _Pragma("unroll") for (int r = 0; r < 16; ++r) { const int n = (t_) * 32 + crow(r, hi); const int dist = tq - (16 * n + 31); s[r] = (dist >= 0 && n < 255) ? s[r] * C2S - slope2 * (float)dist : -INFINITY; tm = fmaxf(tm, s[r]); } \
            tm = fmaxf(tm, __shfl_xor(tm, 32)); \
            const float mn = fmaxf(m, tm), ms_ = (mn == -INFINITY) ? 0.f : mn; float ps = 0.f; \
            _Pragma("unroll") for (int r = 0; r < 16; ++r) ps += __builtin_amdgcn_exp2f(s[r] - ms_); \
            l = l * __builtin_amdgcn_exp2f(m - ms_) + ps; m = mn; } while (0)
        if (nt > 0) {
            CMP_LOADK(kA, 0);
#pragma unroll 1
            for (int t = 0;; t += 2) {
                CMP_LOADK(kB, t + 1 < nt ? t + 1 : nt - 1); CMP_P1(kA, t); if (t + 1 >= nt) break;
                CMP_LOADK(kA, t + 2 < nt ? t + 2 : nt - 1); CMP_P1(kB, t + 1); if (t + 2 >= nt) break;
            }
        }
        l += __shfl_xor(l, 32);
        const float inv = 1.0f / fmaxf(l, 1e-30f), ms = (m == -INFINITY) ? 0.f : m;
        f32x16 o0, o1;
#pragma unroll
        for (int r = 0; r < 16; ++r) { o0[r] = 0.f; o1[r] = 0.f; }
#define CMP_P2(K_, V_, t_) do { f32x16 s = qk_tile(K_, qf); \
            _Pragma("unroll") for (int r = 0; r < 16; ++r) { const int n = (t_) * 32 + crow(r, hi); const int dist = tq - (16 * n + 31); \
                s[r] = (dist >= 0 && n < 255) ? __builtin_amdgcn_exp2f(s[r] * C2S - slope2 * (float)dist - ms) * inv : 0.f; } \
            { float pt_[4]; _Pragma("unroll") for (int a4 = 0; a4 < 4; ++a4) pt_[a4] = __shfl_xor(s[4 * a4 + 3], 32);        \
              _Pragma("unroll") for (int a4 = 0; a4 < 4; ++a4) { const float bs = (s[4 * a4] + s[4 * a4 + 1]) + (s[4 * a4 + 2] + s[4 * a4 + 3]); \
                  const float ad = hi ? pt_[a4] : (a4 ? pt_[a4 ? a4 - 1 : 0] : carry); imps[r32 * 65 + 8 * (t_) + 2 * a4 + hi] = bs + ad; } \
              carry = pt_[3]; } \
            unsigned pk[8]; \
            _Pragma("unroll") for (int j = 0; j < 8; ++j) pk[j] = pg8::cvt_pk_bf16(s[2 * j], s[2 * j + 1]); \
            _Pragma("unroll") for (int i = 0; i < 2; ++i) { const bf16x8 pb = __builtin_bit_cast(bf16x8, (v4u){pk[4 * i], pk[4 * i + 1], pk[4 * i + 2], pk[4 * i + 3]}); \
                o0 = __builtin_amdgcn_mfma_f32_32x32x16_bf16(V_[0][i], pb, o0, 0, 0, 0); o1 = __builtin_amdgcn_mfma_f32_32x32x16_bf16(V_[1][i], pb, o1, 0, 0, 0); } } while (0)
        float carry = 0.f;
        if (nt > 0) {
            CMP_LOADK(kA, 0); CMP_LOADV(vA, 0);
#pragma unroll 1
            for (int t = 0;; t += 2) {
                { const int tn = t + 1 < nt ? t + 1 : nt - 1; CMP_LOADK(kB, tn); CMP_LOADV(vB, tn); } CMP_P2(kA, vA, t); if (t + 1 >= nt) break;
                { const int tn = t + 2 < nt ? t + 2 : nt - 1; CMP_LOADK(kA, tn); CMP_LOADV(vA, tn); } CMP_P2(kB, vB, t + 1); if (t + 2 >= nt) break;
            }
        }
#undef CMP_LOADK
#undef CMP_LOADV
#undef CMP_P1
#undef CMP_P2
        if (nt > 0 && nt < 8 && hi == 0) imps[r32 * 65 + 8 * nt] = carry;
        const float g0 = sigmoidf_(ZS[(rowb + tq) * 16 + 4 + h * 3 + 0]);
        store_ot_bf16((bf16*)(a->ws + WS_OCB) + (rowb + tq) * 256 + h * 64, o0, o1, g0, hi);
    }
    asm volatile("s_waitcnt lgkmcnt(0)" ::: "memory");
}
__device__ __forceinline__ void fa_cmp_topk(CArgsP a, int b, int qt, LAS float* imps, LAS unsigned long long* kl  , int tok0, int ntok, int lane_in) {
    int lane = lane_in; asm volatile("" : "+v"(lane));
    unsigned long long mymask = 0ull; const int curb = qt >> 1;
    const bool causal = lane <= curb; const bool forced = (lane == 0) || (lane == curb) || (lane == curb - 1);
    if (curb < 16) { if (lane < ntok) ((unsigned long long*)(a->ws + WS_MASK))[(size_t)b * SEQ + qt * 32 + tok0 + lane] = (2ull << curb) - 1ull; return; }
    for (int tt = tok0; tt < tok0 + ntok; tt += 2) {
        const float impA = (imps[tt * 65 + lane] + imps[2080 + tt * 65 + lane]) + (imps[2 * 2080 + tt * 65 + lane] + imps[3 * 2080 + tt * 65 + lane]);
        const float impB = (imps[(tt + 1) * 65 + lane] + imps[2080 + (tt + 1) * 65 + lane]) + (imps[2 * 2080 + (tt + 1) * 65 + lane] + imps[3 * 2080 + (tt + 1) * 65 + lane]);
        const unsigned long long keyA = causal ? (((unsigned long long)(forced ? 0x7f800000u : __float_as_uint(impA)) << 32) | (unsigned)(63 - lane)) : 0ull;
        const unsigned long long keyB = causal ? (((unsigned long long)(forced ? 0x7f800000u : __float_as_uint(impB)) << 32) | (unsigned)(63 - lane)) : 0ull;
        kl[lane] = keyA; kl[64 + lane] = keyB;
        int rankA = 0, rankB = 0;
#pragma unroll 2
        for (int jj = 0; jj <= curb; jj += 2) { const v4u twoA = *(const LAS v4u*)(kl + jj), twoB = *(const LAS v4u*)(kl + 64 + jj);
            const unsigned long long a0 = ((unsigned long long)twoA.y << 32) | twoA.x, a1 = ((unsigned long long)twoA.w << 32) | twoA.z;
            const unsigned long long b0 = ((unsigned long long)twoB.y << 32) | twoB.x, b1 = ((unsigned long long)twoB.w << 32) | twoB.z;
            rankA += (a0 > keyA) ? 1 : 0; rankA += (a1 > keyA) ? 1 : 0; rankB += (b0 > keyB) ? 1 : 0; rankB += (b1 > keyB) ? 1 : 0; }
        const unsigned long long mkA = __ballot(rankA < 16 && causal), mkB = __ballot(rankB < 16 && causal);
        if (lane == tt - tok0) mymask = mkA;
        if (lane == tt + 1 - tok0) mymask = mkB;
    }
    if (lane < ntok) ((unsigned long long*)(a->ws + WS_MASK))[(size_t)b * SEQ + qt * 32 + tok0 + lane] = mymask;
    asm volatile("s_waitcnt lgkmcnt(0)" ::: "memory");
}
struct SlcF { int tq; unsigned long long mask; float slope2; bool bit;
    __device__ __forceinline__ void begin_tile(int k0) { bit = (mask >> (k0 >> 6)) & 1ull; }
    __device__ __forceinline__ bool tile_masked(bool diag) const { return diag || !__all(bit); }
    __device__ __forceinline__ float plain(int key, float raw) const { return raw * C2S - slope2 * (float)(tq - key); }
    __device__ __forceinline__ bool valid(int key) const { return bit && key <= tq; } };
struct SlcIt { unsigned long long um; int qt;
    __device__ __forceinline__ int first() const { return um ? 2 * (int)__builtin_ctzll(um) : -1; }
    __device__ __forceinline__ int next(int t) const { if ((t & 1) == 0 && t + 1 <= qt) return t + 1; const int j = t >> 1; if (j >= 63) return -1; const unsigned long long rem = um >> (j + 1); return rem ? 2 * (j + 1 + (int)__builtin_ctzll(rem)) : -1; }
    __device__ __forceinline__ bool masked(int t) const { return t == qt; }
    __device__ __forceinline__ bool block_ok(int) const { return false; }
    __device__ __forceinline__ int clampt(int t) const { return t; } };
__device__ __forceinline__ void fa_nsa_item(CArgsP a, int bh, int qt, int lane_in) {
    int lane = lane_in; asm volatile("" : "+v"(lane));
    const int b = bh >> 2, h = bh & 3, r32 = lane & 31, hi = lane >> 5; const int tq = qt * 32 + r32; const size_t rowb = (size_t)b * SEQ;
    const bf16* Z = (const bf16*)(a->ws + WS_ZH); const float* ZS = (const float*)(a->ws + WS_ZS);
    const float slope2 = alibi_slope(4 + h) * LOG2E;
    bf16x8 qf[4]; load_frag4(qf, Z + (rowb + tq) * ZP + ZQ_NSA + h * 64, hi);
    const unsigned long long mask = ((const unsigned long long*)(a->ws + WS_MASK))[rowb + tq];
    const float g1 = sigmoidf_(ZS[(rowb + tq) * 16 + 4 + h * 3 + 1]), g2 = sigmoidf_(ZS[(rowb + tq) * 16 + 4 + h * 3 + 2]);
    const bf16* oc = (const bf16*)(a->ws + WS_OCB) + (rowb + tq) * 256 + h * 64; bf16* ob = (bf16*)(a->ws + WS_O) + (rowb + tq) * DM + (4 + h) * 64;
    {
        FA st; fa_init(st);
        const bf16* vtl = (const bf16*)(a->ws + WS_VF_NS) + (size_t)b * 128 * 2048; const bf16* Kb = (const bf16*)(a->ws + WS_KF_NS) + (size_t)b * 128 * 2048;
        const SlcF f{tq, mask, slope2, false};
        const int curb = qt >> 1; unsigned long long um = 0ull;
        for (int j = 0; j <= curb; ++j) if (__any((mask >> j) & 1ull)) um |= 1ull << j;
        fa_stream<false, true, true>(st, qf, Kb, (size_t)ZP, vtl, (size_t)SEQ, nullptr, SlcIt{um, qt}, r32, hi, f);
        const float l = st.l + __shfl_xor(st.l, 32); const float sc = g1 / fmaxf(l, 1e-30f);
        store_ot_bf16(ob, st.o0, st.o1, sc, hi);
    }
    asm volatile("" ::: "memory");
    {
        FA st; fa_init(st);
        const bf16* vtl = (const bf16*)(a->ws + WS_VF_NW) + (size_t)b * 128 * 2048;
        int tlo = qt * 32 - 511; tlo = tlo < 0 ? 0 : tlo >> 5;
        fa_stream<false, true, true>(st, qf, (const bf16*)(a->ws + WS_KF_NW) + (size_t)b * 128 * 2048, (size_t)ZP, vtl, (size_t)SEQ, nullptr, RangeIt{tlo, qt, band_tfull(qt * 32, 511)}, r32, hi, BandF{tq, 511, slope2});
        const float l = st.l + __shfl_xor(st.l, 32); const float sc = g2 / l;
#pragma unroll
        for (int a4 = 0; a4 < 4; ++a4) { const u32x2_t x = *(const u32x2_t*)(oc + 8 * a4 + 4 * hi), y = *(const u32x2_t*)(oc + 32 + 8 * a4 + 4 * hi);
            const u32x2_t x2 = *(const u32x2_t*)(ob + 8 * a4 + 4 * hi), y2 = *(const u32x2_t*)(ob + 32 + 8 * a4 + 4 * hi);
            st.o0[4 * a4] = st.o0[4 * a4] * sc + (bflo(x.x) + bflo(x2.x)); st.o0[4 * a4 + 1] = st.o0[4 * a4 + 1] * sc + (bfhi(x.x) + bfhi(x2.x)); st.o0[4 * a4 + 2] = st.o0[4 * a4 + 2] * sc + (bflo(x.y) + bflo(x2.y)); st.o0[4 * a4 + 3] = st.o0[4 * a4 + 3] * sc + (bfhi(x.y) + bfhi(x2.y));
            st.o1[4 * a4] = st.o1[4 * a4] * sc + (bflo(y.x) + bflo(y2.x)); st.o1[4 * a4 + 1] = st.o1[4 * a4 + 1] * sc + (bfhi(y.x) + bfhi(y2.x)); st.o1[4 * a4 + 2] = st.o1[4 * a4 + 2] * sc + (bflo(y.y) + bflo(y2.y)); st.o1[4 * a4 + 3] = st.o1[4 * a4 + 3] * sc + (bfhi(y.y) + bfhi(y2.y)); }
        store_ot_bf16(ob, st.o0, st.o1, 1.0f, hi);
    }
}
#define GAS __attribute__((address_space(1)))
typedef GAS unsigned gu32;
#define XB_TMO      128
#define XB_XCNT(j)  (256  + 64 * (j))
#define XB_XSUB(j)  (1280 + 64 * (j))
#define XB_XGEN(j)  (2304 + 64 * (j))
#define XB_TOP      3328
#define XB_TOPGEN   3392
#define XCD_BAR_WORDS 3456
#define XB_SPIN_CAP (1u << 18)

__device__ __forceinline__ unsigned xb_ld(unsigned* p)              { return __hip_atomic_load(p, __ATOMIC_RELAXED, __HIP_MEMORY_SCOPE_AGENT); }
__device__ __forceinline__ unsigned xb_add(unsigned* p, unsigned v) { return __hip_atomic_fetch_add(p, v, __ATOMIC_RELAXED, __HIP_MEMORY_SCOPE_AGENT); }
__device__ __forceinline__ unsigned xb_xcc_id() { return (unsigned)__builtin_amdgcn_s_getreg((3 << 11) | 20) & 0xFu; }
#define XB_SPIN(cond, bar) do { unsigned _sp = 0; while (cond) { __builtin_amdgcn_s_sleep(1); \
    if ((++_sp & 255u) == 0u) { if (xb_ld(&(bar)[XB_TMO])) break; if (_sp > XB_SPIN_CAP) { atomicAdd(&(bar)[XB_TMO], 1u); break; } } } } while (0)

struct XcdBarrier {
    unsigned* bar; unsigned x;
    volatile LAS unsigned* st;
};

__device__ __forceinline__ XcdBarrier xcd_barrier_post(unsigned* bar, volatile LAS unsigned* st) {
    XcdBarrier b; b.bar = bar; b.x = xb_xcc_id(); b.st = st;
    if (threadIdx.x == 0) (void)xb_add(&bar[XB_XCNT(b.x)], 1u);
    return b;
}
__device__ __forceinline__ void xcd_barrier_complete(unsigned* bar, unsigned x, unsigned& nloc, unsigned& nx) {
    const unsigned G = gridDim.x * gridDim.y * gridDim.z;
    unsigned sum, cnt, mine, sp = 0u;
    for (;;) {
        sum = 0u; cnt = 0u; mine = 0u;
#pragma unroll
        for (unsigned j = 0; j < 16; ++j) { const unsigned c = xb_ld(&bar[XB_XCNT(j)]); sum += c; cnt += (c > 0u) ? 1u : 0u; mine = (j == x) ? c : mine; }
        if (sum == G) break;
        __builtin_amdgcn_s_sleep(1);
        if ((++sp & 255u) == 0u) { if (xb_ld(&bar[XB_TMO])) break; if (sp > XB_SPIN_CAP) { atomicAdd(&bar[XB_TMO], 1u); break; } }
    }
    nloc = mine > 0u ? mine : 1u; nx = cnt > 0u ? cnt : 1u;
}

__device__ __forceinline__ void xcd_barrier(const XcdBarrier& b) {
    asm volatile("s_waitcnt vmcnt(0)" ::: "memory");
    __syncthreads();
    if (threadIdx.x == 0) {
        unsigned* bar = b.bar;
        __builtin_amdgcn_s_waitcnt(0);
        unsigned nloc = b.st[0], nx = b.st[1];
        if (nloc == 0u) { xcd_barrier_complete(bar, b.x, nloc, nx); b.st[0] = nloc; b.st[1] = nx; }
        const unsigned old = xb_add(&bar[XB_XSUB(b.x)], 1u);
        const unsigned gen = old / nloc;
        if (old + 1u == (gen + 1u) * nloc) {
            __builtin_amdgcn_fence(__ATOMIC_RELEASE, "agent");
            asm volatile("s_waitcnt vmcnt(0)" ::: "memory");
            const unsigned og = xb_add(&bar[XB_TOP], 1u);
            const unsigned tg = og / nx;
            if (og + 1u == (tg + 1u) * nx) xb_add(&bar[XB_TOPGEN], 1u);
            else XB_SPIN(xb_ld(&bar[XB_TOPGEN]) == tg, bar);
            __builtin_amdgcn_fence(__ATOMIC_ACQUIRE, "agent");
            xb_add(&bar[XB_XGEN(b.x)], 1u);
            asm volatile("s_waitcnt vmcnt(0)" ::: "memory");
        } else {
            XB_SPIN(xb_ld(&bar[XB_XGEN(b.x)]) == gen, bar);
            __builtin_amdgcn_fence(__ATOMIC_ACQUIRE, "agent");
            asm volatile("s_waitcnt vmcnt(0)" ::: "memory");
        }
    }
    __syncthreads();
}

constexpr size_t WS_BAR = WS_DL + 1536 * 1024;
static_assert(WS_BAR + XCD_BAR_WORDS * 4 <= WS_END, "barrier words inside the small region");
constexpr int LDS_BARST = LDS_BYTES - 64;
#define GRID_BAR() do { CArgsP bp_ = (CArgsP)__builtin_amdgcn_kernarg_segment_ptr(); asm volatile("" : "+s"(bp_)); XcdBarrier xb_; xb_.bar = (unsigned*)(bp_->ws + WS_BAR); xb_.x = xb_xcc_id(); \
    xb_.st = (volatile LAS unsigned*)(lds + LDS_BARST); xcd_barrier(xb_); } while (0)
#define PHASE_ARGS() asm volatile("; PHASE_MARK line %0" :: "i"(__LINE__)); CArgsP ap_ = (CArgsP)__builtin_amdgcn_kernarg_segment_ptr(); asm volatile("" : "+s"(ap_)); \
    CArgsP a = ap_; unsigned char* ws = a->ws; bf16* ZH = (bf16*)(ws + WS_ZH); bf16* XG = (bf16*)(ws + WS_XG); bf16* OB = (bf16*)(ws + WS_O); float* SSQ = (float*)(ws + WS_SSQ); float* ZS = (float*)(ws + WS_ZS); float* X = a->out; \
    (void)ZH; (void)XG; (void)OB; (void)SSQ; (void)ZS; (void)X; int ln = threadIdx.x; asm volatile("" : "+v"(ln)); ln &= 63;
__global__ void __launch_bounds__(NTHR, 2) fwd_megakernel(Args a_unused) {
    extern __shared__ __attribute__((aligned(16))) unsigned char lds_raw[];
    LAS unsigned char* lds = (LAS unsigned char*)lds_raw;
    const int wave = __builtin_amdgcn_readfirstlane(threadIdx.x >> 6);
    const int G = gridDim.x, gw = blockIdx.x * NWAVES + wave, NGW = G * NWAVES;
    const int vcu = (G % 8 == 0) ? (int)(blockIdx.x % 8) * (G / 8) + (int)(blockIdx.x / 8) : (int)blockIdx.x;
    const int gv = vcu * NWAVES + wave;

    if (threadIdx.x < 2) ((LAS unsigned*)(lds + LDS_BARST))[threadIdx.x] = 0u;
    __syncthreads();
    { CArgsP bp_ = (CArgsP)__builtin_amdgcn_kernarg_segment_ptr(); (void)xcd_barrier_post((unsigned*)(bp_->ws + WS_BAR), (volatile LAS unsigned*)(lds + LDS_BARST)); }
    for (int rp = 0; rp < REP_PRO; ++rp)
    { PHASE_ARGS(); prologue(a, lds, gw, NGW, wave, ln); }
    cg::this_grid().sync();

    for (int l = 0; l < DEPTH; ++l) {
        const size_t wlo = WS_W + (size_t)l * LAYER_W;
#if GSEL & 1
        for (int rep = 0; rep < REP_G1; ++rep)
        { PHASE_ARGS(); pg8::Gemm g{XG, (const bf16*)(ws + wlo + OFF_WGU1), M, NGU, DM}; pg8::StaticOrder S; S.init(M, NGU, G, (int)blockIdx.x);
          pg8::EpiSwiglu E{ZH, SSQ, DFF};
          pg8::gemm_phase<pg8::EpiSwiglu, pg8::StaticOrder, true, true>(lds, g, S, E); }
#endif
        GRID_BAR();
#if GSEL & 2
        { PHASE_ARGS(); pg8::Gemm g{ZH, (const bf16*)(ws + wlo + OFF_WD1), M, DM, DFF}; pg8::StaticOrder S; S.init(M, DM, G, (int)blockIdx.x);
          pg8::EpiResid E{l == 0 ? a->in[0] : X, X, XG, a->in[5] + l * DM, SSQ, 0.5f};
          pg8::gemm_phase<pg8::EpiResid, pg8::StaticOrder, true, true>(lds, g, S, E); }
#endif
        GRID_BAR();
#if GSEL & 4
        { PHASE_ARGS(); pg8::Gemm g{XG, (const bf16*)(ws + wlo + OFF_WIN), M, ZP, DM}; pg8::StaticOrder S; S.init(M, ZP, G, (int)blockIdx.x);
          pg8::EpiZ E{ZH, ZS, SSQ, ZP, (bf16*)(ws + WS_KF_FOX), (bf16*)(ws + WS_KF_NS), (bf16*)(ws + WS_KF_NW)};
          pg8::gemm_phase<pg8::EpiZ, pg8::StaticOrder, true, true>(lds, g, S, E); }
#endif
        GRID_BAR();
        for (int rep = 0; rep < REP_P4; ++rep) {
        { PHASE_ARGS();
          for (int it = blockIdx.x; it < 32 + 256; it += G) { if (it < 32) p4_cumsum(a, l, lds, it); else p4_compress(a, l, lds, it - 32); }
          for (int it = gw; it < 14336; it += NGW) p4_vfrag2_item(a, it, (LAS unsigned short*)(lds + wave * 16640), ln);
          for (int it = gw; it < 6144; it += NGW) p4_vfrag_item(a, it, (LAS unsigned short*)(lds + wave * 16640), ln);
#if !FA_DIL
          for (int it = gw; it < 6144; it += NGW) p4_dil_item(a, it, ln);
#endif
#if !FA_SWA
          for (int it = gw; it < 2048; it += NGW) p4_swa_item(a, l, it, ln);
#endif
        }
        GRID_BAR(); }
        for (int rep = 0; rep < REP_P5; ++rep) {
        { PHASE_ARGS();
#if FA_FOX
          for (int rp = 0; rp < REP_FOX; ++rp)
          for (int i = gv; i < 2048; i += NGW) { fa_fox_item(a, i >> 6, 127 - (i & 63), ln); fa_fox_item(a, i >> 6, i & 63, ln); }
#else
          for (int it = gw; it < 2048; it += NGW) p5_fox_item(a, it, ln);
#endif
#if FA_CMP
          for (int rp = 0; rp < REP_CMP; ++rp)
          for (int rd = vcu; rd < 256; rd += G) {
              const int cb = rd >> 5, ck = rd & 31, slot = wave >> 1, hp = wave & 1;
#define CMP_QT(s_) ((s_) == 0 ? ck : ((s_) == 1 ? 63 - ck : ((s_) == 2 ? 64 + ck : 127 - ck)))
              const int cqt = CMP_QT(slot);
              LAS float* imps = (LAS float*)(lds + slot * 4 * 8320);
              for (int rq = 0; rq < REP_CPASS; ++rq)
              { const int hh = wave & 3, s1 = wave < 4 ? 3 : 2, s2 = wave < 4 ? 0 : 1;
                fa_cmp_passes(a, cb, CMP_QT(s1), hh, hh + 1, (LAS float*)(lds + (s1 * 4 + hh) * 8320), ln);
                fa_cmp_passes(a, cb, CMP_QT(s2), hh, hh + 1, (LAS float*)(lds + (s2 * 4 + hh) * 8320), ln); }
#undef CMP_QT
              __syncthreads();
              for (int rq = 0; rq < REP_CTOPK; ++rq) fa_cmp_topk(a, cb, cqt, imps, (LAS unsigned long long*)(lds + 133120 + wave * 1024), 16 * hp, 16, ln);
              __syncthreads();
          }
#else
          for (int it = gw; it < 512; it += NGW) p5_cmp_item(a, it, (LAS float*)(lds + wave * 16640), ln);
#endif
#if FA_SWA
          for (int it = gv; it < 4096; it += NGW) fa_swa_item(a, l, it, ln);
#endif
#if FA_DIL
          for (int rp = 0; rp < REP_DIL; ++rp)
          for (int it = gv; it < 12288; it += NGW) fa_dil_item(a, it, ln);
#else
          for (int it = gw; it < 2048; it += NGW) p5_dilcomb_item(a, it, ln);
#endif
        }
        GRID_BAR(); }
        for (int rep = 0; rep < REP_P6; ++rep) {
        { PHASE_ARGS();
#if FA_NSA
          for (int i = gv; i < 2048; i += NGW) { fa_nsa_item(a, i >> 6, 127 - (i & 63), ln); fa_nsa_item(a, i >> 6, i & 63, ln); }
#else
          for (int it = gw; it < 2048; it += NGW) p6_nsa_item(a, it, ln);
#endif
#if FA_DIL
          for (int it = gw; it < 2048; it += NGW) p5_dilcomb_item(a, it, ln);
#endif
        }
        GRID_BAR(); }
#if GSEL & 8
        { PHASE_ARGS(); pg8::Gemm g{OB, (const bf16*)(ws + wlo + OFF_WOUT), M, DM, DM}; pg8::StaticOrder S; S.init(M, DM, G, (int)blockIdx.x);
          pg8::EpiResid E{X, X, XG, a->in[13] + l * DM, SSQ, 1.0f};
          pg8::gemm_phase<pg8::EpiResid, pg8::StaticOrder, true, true>(lds, g, S, E); }
#endif
        GRID_BAR();
#if GSEL & 1
        { PHASE_ARGS(); pg8::Gemm g{XG, (const bf16*)(ws + wlo + OFF_WGU2), M, NGU, DM}; pg8::StaticOrder S; S.init(M, NGU, G, (int)blockIdx.x);
          pg8::EpiSwiglu E{ZH, SSQ, DFF};
          pg8::gemm_phase<pg8::EpiSwiglu, pg8::StaticOrder, true, true>(lds, g, S, E); }
#endif
        GRID_BAR();
#if GSEL & 2
        { PHASE_ARGS(); pg8::Gemm g{ZH, (const bf16*)(ws + wlo + OFF_WD2), M, DM, DFF}; pg8::StaticOrder S; S.init(M, DM, G, (int)blockIdx.x);
          pg8::EpiResid E{X, X, XG, l + 1 < DEPTH ? a->in[1] + (l + 1) * DM : a->in[17], SSQ, 0.5f};
          pg8::gemm_phase<pg8::EpiResid, pg8::StaticOrder, true, true>(lds, g, S, E); }
#endif
        GRID_BAR();
    }
#ifdef EXTRA_SYNCS
    for (int i = 0; i < EXTRA_SYNCS; ++i) GRID_BAR();
#endif
    { PHASE_ARGS(); const int lane = ln; const float* gf = a->in[17]; f32x4 gv[4];
#pragma unroll
      for (int j = 0; j < 4; ++j) gv[j] = *(const f32x4*)(gf + 4 * lane + 256 * j);
      for (int m = gw; m < M; m += NGW) {
          const f32x4 p = *(const f32x4*)(SSQ + (size_t)m * 16 + 4 * (lane & 3)); float s = (p[0] + p[1]) + (p[2] + p[3]); s += __shfl_xor(s, 1); s += __shfl_xor(s, 2);
          const float rs = 1.0f / sqrtf(s * (1.0f / 1024.0f) + 1e-6f);
          f32x4* xr = (f32x4*)(X + (size_t)m * DM) + lane;
#pragma unroll
          for (int j = 0; j < 4; ++j) { f32x4 v = xr[64 * j]; v = v * gv[j] * rs; xr[64 * j] = v; } } }
}

extern "C" void kernel_launch(void* const* d_in, const int* in_sizes, int n_in, void* d_out, int out_size, void* d_ws, size_t ws_size, hipStream_t stream) {
    static int grid = 0;
    if (grid == 0) {
        if (n_in != 18 || out_size != M * DM || ws_size < 512 * MiB) { fprintf(stderr, "kernel_launch: unexpected shapes (n_in %d out %d ws %zu)\n", n_in, out_size, ws_size); grid = -1; return; }
        int dev = 0, cus = 0, per_cu = 0;
        (void)hipGetDevice(&dev); (void)hipDeviceGetAttribute(&cus, hipDeviceAttributeMultiprocessorCount, dev);
        if (hipFuncSetAttribute((const void*)fwd_megakernel, hipFuncAttributeMaxDynamicSharedMemorySize, LDS_BYTES) != hipSuccess) { fprintf(stderr, "hipFuncSetAttribute failed\n"); grid = -1; return; }
        if (hipOccupancyMaxActiveBlocksPerMultiprocessor(&per_cu, (const void*)fwd_megakernel, NTHR, LDS_BYTES) != hipSuccess || per_cu < 1) { fprintf(stderr, "occupancy query: %d\n", per_cu); per_cu = 1; }
        (void)hipGetLastError();
        grid = cus;
        if (grid <= 0) grid = 256;
    }
    if (grid < 0) return;
    if (hipMemsetAsync((char*)d_ws + WS_BAR, 0, XCD_BAR_WORDS * 4, stream) != hipSuccess) { fprintf(stderr, "memset of the barrier words failed\n"); return; }
    Args a{};
    for (int i = 0; i < 18; ++i) a.in[i] = (const float*)d_in[i];
    a.out = (float*)d_out; a.ws = (unsigned char*)d_ws;
    void* args[] = {&a};
    hipError_t e = hipLaunchCooperativeKernel((const void*)fwd_megakernel, dim3(grid), dim3(NTHR), args, LDS_BYTES, stream);
    if (e != hipSuccess) fprintf(stderr, "cooperative launch failed: %s (grid %d)\n", hipGetErrorString(e), grid);
}
```
